# Optimizing an MI355X kernel written in HIP

```python
import math
import jax, jax.numpy as jnp
from jax import lax
import numpy as np

D_MODEL = 1024
BATCH = 8
SEQ = 4096
DEPTH = 1

D_MIX = D_MODEL
ATTN_HEADS = 8
ATTN_HEAD_DIM = 64
ATTN_WIDTH = ATTN_HEADS * ATTN_HEAD_DIM
MLSTM_HEADS = 4
MLSTM_HEAD_DIM = 128
MLSTM_WIDTH = MLSTM_HEADS * MLSTM_HEAD_DIM
DILATED_PATTERNS = ((128, 1), (512, 4), (2048, 16))
ATTN_BLOCK = 128
ROPE_THETA = 500000.0
ROPE_DIM = ATTN_HEAD_DIM // 4
CONV_WIDTH = 4
MLSTM_CHUNK = 64
D_FF = 4 * D_MODEL
PLE_DIM = 256
RMS_EPS = 1e-6
IN_PROJ_WIDTH = 3 * ATTN_WIDTH + 4 * MLSTM_WIDTH + 2 * MLSTM_HEADS

kernel_name = "hymba_dilated_attn_mlstm_block"


def rms_norm(x, g):
    xf = x.astype(jnp.float32)
    y = xf * lax.rsqrt(jnp.mean(xf * xf, axis=-1, keepdims=True) + RMS_EPS)
    return (y * g.astype(jnp.float32)).astype(x.dtype)


def partial_rope(x, pos):
    half = ROPE_DIM // 2
    inv_freq = jnp.power(ROPE_THETA, -jnp.arange(half, dtype=jnp.float32) / half)
    ang = pos.astype(jnp.float32)[:, None] * inv_freq[None, :]
    cos, sin = jnp.cos(ang), jnp.sin(ang)
    xr = x[..., :ROPE_DIM].astype(jnp.float32)
    x1, x2 = xr[..., :half], xr[..., half:]
    rot = jnp.concatenate([x1 * cos - x2 * sin, x2 * cos + x1 * sin], axis=-1)
    return jnp.concatenate([rot.astype(x.dtype), x[..., ROPE_DIM:]], axis=-1)


def dilated_window_partial(q, k, v, window, dilation):
    B, H, S, hd = q.shape
    n_back = window // dilation
    L = S // dilation
    nb = -(-L // ATTN_BLOCK)
    Lp = nb * ATTN_BLOCK
    blk = ATTN_BLOCK

    def to_sub(t):
        t = t.reshape(B, H, L, dilation, hd).transpose(0, 1, 3, 2, 4)
        t = jnp.pad(t, ((0, 0), (0, 0), (0, 0), (0, Lp - L), (0, 0)))
        return t.reshape(B, H, dilation, nb, blk, hd)

    def with_prev(t):
        prev = jnp.pad(t, ((0, 0), (0, 0), (0, 0), (1, 0), (0, 0), (0, 0)))[:, :, :, :-1]
        return jnp.concatenate([prev, t], axis=4)

    qs = to_sub(q)
    kb = with_prev(to_sub(k))
    vb = with_prev(to_sub(v))
    s = jnp.einsum('bhrnqd,bhrnkd->bhrnqk', qs, kb) * (1.0 / math.sqrt(hd))
    qi = jnp.arange(blk)[:, None]
    ki = jnp.arange(2 * blk)[None, :]
    dist = qi + blk - ki
    key_pos = jnp.arange(nb)[:, None, None] * blk + ki[None] - blk
    valid = (dist >= 0) & (dist <= n_back) & (key_pos >= 0)
    s = jnp.where(valid, s, -jnp.inf)
    m = jnp.max(s, axis=-1)
    pexp = jnp.exp(s - m[..., None])
    den = jnp.sum(pexp, axis=-1)
    num = jnp.einsum('bhrnqk,bhrnkd->bhrnqd', pexp, vb)

    def back_vec(t):
        t = t.reshape(B, H, dilation, Lp, hd)[:, :, :, :L]
        return t.transpose(0, 1, 3, 2, 4).reshape(B, H, S, hd)

    def back_scalar(t):
        t = t.reshape(B, H, dilation, Lp)[:, :, :, :L]
        return t.transpose(0, 1, 3, 2).reshape(B, H, S)

    return back_vec(num), back_scalar(m), back_scalar(den)


def dilated_attention(q, k, v):
    parts = [dilated_window_partial(q, k, v, w, d) for (w, d) in DILATED_PATTERNS]
    m_all = jnp.max(jnp.stack([pm for (_, pm, _) in parts]), axis=0)
    num = sum(pn * jnp.exp(pm - m_all)[..., None] for (pn, pm, _) in parts)
    den = sum(pd * jnp.exp(pm - m_all) for (_, pm, pd) in parts)
    return num / den[..., None]


def mlstm_chunkwise(q, k, v, i_pre, f_pre):
    B, H, S, dh = q.shape
    Lc = MLSTM_CHUNK
    nc = S // Lc
    k = k * (1.0 / math.sqrt(dh))
    logf = jax.nn.log_sigmoid(f_pre)

    def chunks(t):
        t = t.reshape(B, H, nc, Lc, *t.shape[3:])
        return jnp.moveaxis(t, 2, 0)

    xs = (chunks(q), chunks(k), chunks(v), chunks(i_pre), chunks(logf))
    causal = jnp.tril(jnp.ones((Lc, Lc), dtype=bool))

    def step(carry, inp):
        C, n, m = carry
        qc, kc, vc, ic, fc = inp
        b = jnp.cumsum(fc, axis=-1)
        log_d = b[..., :, None] - b[..., None, :] + ic[..., None, :]
        log_d = jnp.where(causal, log_d, -jnp.inf)
        log_inter = b + m[..., None]
        m_t = jnp.maximum(log_inter, jnp.max(log_d, axis=-1))
        w_intra = jnp.exp(log_d - m_t[..., None])
        w_inter = jnp.exp(log_inter - m_t)
        qk = jnp.einsum('bhtd,bhsd->bhts', qc, kc) * w_intra
        num = (w_inter[..., None] * jnp.einsum('bhtd,bhde->bhte', qc, C)
               + jnp.einsum('bhts,bhse->bhte', qk, vc))
        den = w_inter * jnp.einsum('bhtd,bhd->bht', qc, n) + jnp.sum(qk, axis=-1)
        h = num / jnp.maximum(jnp.abs(den), jnp.exp(-m_t))[..., None]
        b_last = b[..., -1]
        log_s = b_last[..., None] - b + ic
        m_new = jnp.maximum(b_last + m, jnp.max(log_s, axis=-1))
        decay = jnp.exp(b_last + m - m_new)
        ws = jnp.exp(log_s - m_new[..., None])
        C_new = decay[..., None, None] * C + jnp.einsum('bhs,bhsd,bhse->bhde', ws, kc, vc)
        n_new = decay[..., None] * n + jnp.einsum('bhs,bhsd->bhd', ws, kc)
        return (C_new, n_new, m_new), h

    init = (jnp.zeros((B, H, dh, dh), jnp.float32),
            jnp.zeros((B, H, dh), jnp.float32),
            jnp.zeros((B, H), jnp.float32))
    _, hs = lax.scan(step, init, xs)
    return jnp.moveaxis(hs, 0, 2).reshape(B, H, S, dh)


def causal_short_conv(x, w, b):
    S = x.shape[1]
    xp = jnp.pad(x, ((0, 0), (CONV_WIDTH - 1, 0), (0, 0)))
    return sum(w[j] * xp[:, j:j + S] for j in range(CONV_WIDTH)) + b


def split_heads(t, n_heads, hd):
    B, S, _ = t.shape
    return t.reshape(B, S, n_heads, hd).transpose(0, 2, 1, 3)


def merge_heads(t):
    B, H, S, hd = t.shape
    return t.transpose(0, 2, 1, 3).reshape(B, S, H * hd)


def setup_inputs(seed: int = 0) -> dict:
    key = jax.random.key(seed)
    ks = jax.random.split(key, 20)
    f32 = jnp.float32

    def nrm(k, shape, scale):
        return jax.random.normal(k, shape, f32) * scale

    x = jax.random.normal(ks[0], (BATCH, SEQ, D_MODEL), f32)
    p = jax.random.normal(ks[1], (DEPTH, BATCH, SEQ, PLE_DIM), f32)
    norm_mix_g = 1.0 + nrm(ks[2], (DEPTH, D_MODEL), 0.02)
    w_in = nrm(ks[3], (DEPTH, D_MODEL, IN_PROJ_WIDTH), D_MODEL ** -0.5)
    conv_w = nrm(ks[4], (DEPTH, CONV_WIDTH, 2 * MLSTM_WIDTH), CONV_WIDTH ** -0.5)
    conv_b = nrm(ks[5], (DEPTH, 2 * MLSTM_WIDTH), 0.01)
    i_bias = nrm(ks[6], (DEPTH, MLSTM_HEADS), 0.1)
    f_bias = (jnp.linspace(3.0, 6.0, MLSTM_HEADS, dtype=f32)[None, :]
              + nrm(ks[7], (DEPTH, MLSTM_HEADS), 0.1))
    gate_b = jnp.concatenate([i_bias, f_bias], axis=-1)
    mlstm_norm_g = 1.0 + nrm(ks[8], (DEPTH, MLSTM_WIDTH), 0.02)
    w_out = nrm(ks[9], (DEPTH, D_MIX, D_MODEL), D_MIX ** -0.5)
    norm_mlp_g = 1.0 + nrm(ks[10], (DEPTH, D_MODEL), 0.02)
    w_up = nrm(ks[11], (DEPTH, D_MODEL, D_FF), D_MODEL ** -0.5)
    w_down = nrm(ks[12], (DEPTH, D_FF, D_MODEL), D_FF ** -0.5)
    norm_ple_g = 1.0 + nrm(ks[13], (DEPTH, D_MODEL), 0.02)
    w_ple_gate = nrm(ks[14], (DEPTH, D_MODEL, D_MODEL), D_MODEL ** -0.5)
    w_ple = nrm(ks[15], (DEPTH, PLE_DIM, D_MODEL), PLE_DIM ** -0.5)
    final_norm_g = 1.0 + nrm(ks[16], (D_MODEL,), 0.02)
    return {"x": x, "p": p, "norm_mix_g": norm_mix_g, "w_in": w_in,
            "conv_w": conv_w, "conv_b": conv_b, "gate_b": gate_b,
            "mlstm_norm_g": mlstm_norm_g, "w_out": w_out, "norm_mlp_g": norm_mlp_g,
            "w_up": w_up, "w_down": w_down, "norm_ple_g": norm_ple_g,
            "w_ple_gate": w_ple_gate, "w_ple": w_ple, "final_norm_g": final_norm_g}


def reference(x, p, norm_mix_g, w_in, conv_w, conv_b, gate_b, mlstm_norm_g, w_out,
              norm_mlp_g, w_up, w_down, norm_ple_g, w_ple_gate, w_ple, final_norm_g):
    B, S, _ = x.shape
    pos = jnp.arange(S, dtype=jnp.int32)
    A, M = ATTN_WIDTH, MLSTM_WIDTH
    h = x
    for layer in range(DEPTH):
        u = rms_norm(h, norm_mix_g[layer])
        proj = u @ w_in[layer]
        aq = proj[..., 0:A]
        ak = proj[..., A:2 * A]
        av = proj[..., 2 * A:3 * A]
        o0 = 3 * A
        mqk = proj[..., o0:o0 + 2 * M]
        mv = proj[..., o0 + 2 * M:o0 + 3 * M]
        mo = proj[..., o0 + 3 * M:o0 + 4 * M]
        gates = (proj[..., o0 + 4 * M:] + gate_b[layer]).astype(jnp.float32)

        qa = partial_rope(split_heads(aq, ATTN_HEADS, ATTN_HEAD_DIM), pos).astype(jnp.float32)
        ka = partial_rope(split_heads(ak, ATTN_HEADS, ATTN_HEAD_DIM), pos).astype(jnp.float32)
        va = split_heads(av, ATTN_HEADS, ATTN_HEAD_DIM).astype(jnp.float32)
        attn_out = merge_heads(dilated_attention(qa, ka, va)).astype(h.dtype)

        qk_c = jax.nn.silu(causal_short_conv(mqk, conv_w[layer], conv_b[layer]))
        qm = split_heads(qk_c[..., :M], MLSTM_HEADS, MLSTM_HEAD_DIM).astype(jnp.float32)
        km = split_heads(qk_c[..., M:], MLSTM_HEADS, MLSTM_HEAD_DIM).astype(jnp.float32)
        vm = split_heads(mv, MLSTM_HEADS, MLSTM_HEAD_DIM).astype(jnp.float32)
        i_pre = gates[..., :MLSTM_HEADS].transpose(0, 2, 1)
        f_pre = gates[..., MLSTM_HEADS:].transpose(0, 2, 1)
        hm = mlstm_chunkwise(qm, km, vm, i_pre, f_pre)
        hm = hm * lax.rsqrt(jnp.mean(hm * hm, axis=-1, keepdims=True) + RMS_EPS)
        hm = hm * mlstm_norm_g[layer].astype(jnp.float32).reshape(MLSTM_HEADS, 1, MLSTM_HEAD_DIM)
        mlstm_out = (jax.nn.sigmoid(mo.astype(jnp.float32)) * merge_heads(hm)).astype(h.dtype)

        mix = jnp.concatenate([attn_out, mlstm_out], axis=-1)
        h = h + mix @ w_out[layer]

        u = rms_norm(h, norm_mlp_g[layer])
        h = h + jnp.square(jax.nn.relu(u @ w_up[layer])) @ w_down[layer]

        gate = jax.nn.sigmoid(rms_norm(h, norm_ple_g[layer]) @ w_ple_gate[layer])
        h = h + gate * (p[layer] @ w_ple[layer])
    return rms_norm(h, final_norm_g)
```

```cpp
#include <hip/hip_runtime.h>
#include <hip/hip_cooperative_groups.h>
#include <cstdio>
#include <cstdint>
namespace cg = cooperative_groups;
#ifndef MK_LAUNCHES
#define MK_LAUNCHES 1
#endif
namespace pg8 {
#define PG8_LAS __attribute__((address_space(3)))
typedef unsigned short bf16_t;
typedef short bf16x8 __attribute__((ext_vector_type(8)));
typedef float f32x4 __attribute__((ext_vector_type(4)));
typedef unsigned u32x4 __attribute__((ext_vector_type(4)));
constexpr int BM = 256, BK = 64, HALF = 128, HTB = HALF * BK * 2  , STAGE_BYTES = 8 * HTB, NXCD = 8, WGM = 8;

__host__ __device__ __forceinline__ int lds_byte(int r, int c) { const int st = (r >> 4) * 2 + (c >> 5), rr = r & 15, cc = c & 31, ob = rr * 64 + cc * 2; return st * 1024 + (ob ^ (((ob >> 9) & 1) << 5)); }
__host__ __device__ __forceinline__ void stage_rc(int b, int& R, int& C) { const int st = b / 1024, sb = b % 1024, swz = sb ^ (((sb >> 9) & 1) << 5); R = (st >> 1) * 16 + swz / 64; C = (st & 1) * 32 + (swz % 64) / 2; }
__host__ __device__ __forceinline__ int perm32(int rho) { const int n = rho >> 4, i = rho & 15; return 8 * (i >> 2) + 4 * n + (i & 3); }

struct Unit { int pm, pn; };
struct Gemm { const bf16_t* A; const bf16_t* Bt; int M, N, K; };

struct StaticOrder {
    int nM, nN, nwg, G, c;
    __host__ __device__ void init(int M, int N, int G_, int c_) { nM = M / BM; nN = N / BM; nwg = nM * nN; G = G_; c = c_; }
    __host__ __device__ bool next(int i, Unit& u) const {
        const long L = (long)i * G + c; if (L >= nwg) return false;
        int wgid = (int)L; { const int q = nwg / NXCD, r = nwg % NXCD, xcd = wgid % NXCD, off = wgid / NXCD; wgid = (xcd < r ? xcd * (q + 1) : r * (q + 1) + (xcd - r) * q) + off; }
        const int nig = WGM * nN, gid = wgid / nig, fm = gid * WGM, gsz = (nM - fm) < WGM ? (nM - fm) : WGM;
        u.pm = fm + ((wgid % nig) % gsz); u.pn = (wgid % nig) / gsz; return true;
    }
    __device__ __forceinline__ void a_ready(const Unit&) const {}
    __device__ __forceinline__ void done(const Unit&) const {}
};
__device__ __forceinline__ unsigned cvt_pk_bf16(float lo, float hi) { unsigned r; asm volatile("v_cvt_pk_bf16_f32 %0, %1, %2" : "=v"(r) : "v"(lo), "v"(hi)); return r; }
constexpr float RMS_EPS_F = 1e-6f;
__device__ __forceinline__ float bf_lo(unsigned w) { return __builtin_bit_cast(float, w << 16); }
__device__ __forceinline__ float bf_hi(unsigned w) { return __builtin_bit_cast(float, w & 0xffff0000u); }
__device__ __forceinline__ float row_rs(const float* ssq, int row) {
    const f32x4* sp = (const f32x4*)(ssq + (size_t)row * 16);
    const f32x4 t = (sp[0] + sp[1]) + (sp[2] + sp[3]);
    return __builtin_amdgcn_rsqf(((t[0] + t[1]) + (t[2] + t[3])) * (1.0f / 1024.0f) + RMS_EPS_F);
}
struct EpiStoreBf16 {
    static constexpr bool PERM = true, AFTER_DRAIN = false;
    bf16_t* O; int ldc;
    __device__ __forceinline__ void operator()(const f32x4 (&acc)[2][2][4][2], const Unit& u, int wr, int wc, int fr, int fq) const {
        const int row0 = u.pm * BM + wr * 64 + fr, col0 = u.pn * BM + wc * 32 + 8 * fq;
#pragma unroll
        for (int ai = 0; ai < 2; ++ai)
#pragma unroll
            for (int m = 0; m < 4; ++m) { bf16_t* rowp = O + (size_t)(row0 + ai * HALF + m * 16) * ldc + col0;
#pragma unroll
                for (int bj = 0; bj < 2; ++bj) { const f32x4 v0 = acc[ai][bj][m][0], v1 = acc[ai][bj][m][1];
                    u32x4 w; w.x = cvt_pk_bf16(v0[0], v0[1]); w.y = cvt_pk_bf16(v0[2], v0[3]); w.z = cvt_pk_bf16(v1[0], v1[1]); w.w = cvt_pk_bf16(v1[2], v1[3]);
                    *(u32x4*)(rowp + bj * HALF) = w; } }
    }
};
struct EpiRes {
    static constexpr bool PERM = true, AFTER_DRAIN = false;
    const float* base; float* H; bf16_t* HB; float* SSQ;
    __device__ __forceinline__ void operator()(const f32x4 (&acc)[2][2][4][2], const Unit& u, int wr, int wc, int fr, int fq) const {
        const int row0 = u.pm * BM + wr * 64 + fr, col0 = u.pn * BM + wc * 32 + 8 * fq;
#pragma unroll
        for (int ai = 0; ai < 2; ++ai)
#pragma unroll
            for (int m = 0; m < 4; ++m) { const int row = row0 + ai * HALF + m * 16; const size_t ro = (size_t)row * 1024 + col0; float ss = 0.f;
#pragma unroll
                for (int bj = 0; bj < 2; ++bj) {
                    const f32x4 b0 = *(const f32x4*)(base + ro + bj * HALF), b1 = *(const f32x4*)(base + ro + bj * HALF + 4);
                    const f32x4 v0 = acc[ai][bj][m][0] + b0, v1 = acc[ai][bj][m][1] + b1;
                    *(f32x4*)(H + ro + bj * HALF) = v0; *(f32x4*)(H + ro + bj * HALF + 4) = v1;
                    u32x4 w; w.x = cvt_pk_bf16(v0[0], v0[1]); w.y = cvt_pk_bf16(v0[2], v0[3]); w.z = cvt_pk_bf16(v1[0], v1[1]); w.w = cvt_pk_bf16(v1[2], v1[3]);
                    *(u32x4*)(HB + ro + bj * HALF) = w;
                    ss += (v0[0] * v0[0] + v0[1] * v0[1]) + (v0[2] * v0[2] + v0[3] * v0[3]) + (v1[0] * v1[0] + v1[1] * v1[1]) + (v1[2] * v1[2] + v1[3] * v1[3]); }
                ss += __shfl_xor(ss, 16); ss += __shfl_xor(ss, 32);
                if (fq == 0) SSQ[(size_t)row * 16 + u.pn * 4 + wc] = ss; }
    }
};
struct EpiUp {
    static constexpr bool PERM = true, AFTER_DRAIN = false;
    bf16_t* O; const float* SSQ;
    __device__ __forceinline__ void operator()(const f32x4 (&acc)[2][2][4][2], const Unit& u, int wr, int wc, int fr, int fq) const {
        const int row0 = u.pm * BM + wr * 64 + fr, col0 = u.pn * BM + wc * 32 + 8 * fq;
#pragma unroll
        for (int ai = 0; ai < 2; ++ai)
#pragma unroll
            for (int m = 0; m < 4; ++m) { const int row = row0 + ai * HALF + m * 16; const float rs = row_rs(SSQ, row); bf16_t* rowp = O + (size_t)row * 4096 + col0;
#pragma unroll
                for (int bj = 0; bj < 2; ++bj) { f32x4 v0 = acc[ai][bj][m][0] * rs, v1 = acc[ai][bj][m][1] * rs;
#pragma unroll
                    for (int j = 0; j < 4; ++j) { const float a = fmaxf(v0[j], 0.f), b = fmaxf(v1[j], 0.f); v0[j] = a * a; v1[j] = b * b; }
                    u32x4 w; w.x = cvt_pk_bf16(v0[0], v0[1]); w.y = cvt_pk_bf16(v0[2], v0[3]); w.z = cvt_pk_bf16(v1[0], v1[1]); w.w = cvt_pk_bf16(v1[2], v1[3]);
                    *(u32x4*)(rowp + bj * HALF) = w; } }
    }
};
struct EpiPle {
    static constexpr bool PERM = true, AFTER_DRAIN = false;
    float* H; const bf16_t* E; const float* SSQ; float* SSQO;
    __device__ __forceinline__ void operator()(const f32x4 (&acc)[2][2][4][2], const Unit& u, int wr, int wc, int fr, int fq) const {
        const int row0 = u.pm * BM + wr * 64 + fr, col0 = u.pn * BM + wc * 32 + 8 * fq;
#pragma unroll
        for (int ai = 0; ai < 2; ++ai)
#pragma unroll
            for (int m = 0; m < 4; ++m) { const int row = row0 + ai * HALF + m * 16; const float rs = row_rs(SSQ, row); const size_t ro = (size_t)row * 1024 + col0; float ss = 0.f;
#pragma unroll
                for (int bj = 0; bj < 2; ++bj) {
                    const f32x4 b0 = *(const f32x4*)(H + ro + bj * HALF), b1 = *(const f32x4*)(H + ro + bj * HALF + 4);
                    const u32x4 ew = *(const u32x4*)(E + ro + bj * HALF);
                    const f32x4 e0 = (f32x4){bf_lo(ew.x), bf_hi(ew.x), bf_lo(ew.y), bf_hi(ew.y)}, e1 = (f32x4){bf_lo(ew.z), bf_hi(ew.z), bf_lo(ew.w), bf_hi(ew.w)};
                    f32x4 v0, v1;
#pragma unroll
                    for (int j = 0; j < 4; ++j) {
                        const float g0 = 1.0f / (1.0f + __expf(-acc[ai][bj][m][0][j] * rs)), g1 = 1.0f / (1.0f + __expf(-acc[ai][bj][m][1][j] * rs));
                        v0[j] = b0[j] + g0 * e0[j]; v1[j] = b1[j] + g1 * e1[j]; }
                    *(f32x4*)(H + ro + bj * HALF) = v0; *(f32x4*)(H + ro + bj * HALF + 4) = v1;
                    ss += (v0[0] * v0[0] + v0[1] * v0[1]) + (v0[2] * v0[2] + v0[3] * v0[3]) + (v1[0] * v1[0] + v1[1] * v1[1]) + (v1[2] * v1[2] + v1[3] * v1[3]); }
                ss += __shfl_xor(ss, 16); ss += __shfl_xor(ss, 32);
                if (fq == 0) SSQO[(size_t)row * 16 + u.pn * 4 + wc] = ss; }
    }
};
template <class Epi, class Sched, bool STAMP = false>
__device__ __forceinline__ void gemm_phase(PG8_LAS unsigned char* lds, const Gemm g, const Sched& S, const Epi& E, unsigned long long* stamps) {
    const int tid = threadIdx.x, wid = __builtin_amdgcn_readfirstlane(tid >> 6), lane = tid & 63, wr = wid >> 2, wc = wid & 3, fr = lane & 15, fq = lane >> 4;
    const int K = g.K, nt = K / BK;
    int ts_lo = 0, ts_hi = 0, nts = 0; const unsigned long long rt_entry = STAMP ? (unsigned long long)wall_clock64() : 0ull;
#define PG8_STAMP() do { if (STAMP && wid == 0 && nts < 64) { const unsigned long long _c = (unsigned long long)clock64(); \
        ts_lo = (lane == nts) ? (int)(unsigned)_c : ts_lo; ts_hi = (lane == nts) ? (int)(unsigned)(_c >> 32) : ts_hi; ++nts; } } while (0)
    PG8_STAMP();
    unsigned voffA[2], voffB[2];
#pragma unroll
    for (int i = 0; i < 2; ++i) { int R, C; stage_rc(tid * 16 + i * 8192, R, C); const int Rb = Epi::PERM ? ((R & ~31) + perm32(R & 31)) : R;
        voffA[i] = (unsigned)(R * K + C) * 2u; voffB[i] = (unsigned)(Rb * K + C) * 2u; }
    const size_t kstep = (size_t)(BK * 2);
    const size_t hstep = (size_t)HALF * K * 2;
    const size_t tstep = 2 * hstep;
    const unsigned ldsw = (unsigned)wid * 1024u;
    const int aoff = lds_byte(wr * 64 + fr, fq * 8), boff = lds_byte(wc * 32 + fr, fq * 8);
#define PG8_SA(b, h) (((b) * 2 + (h)) * HTB)
#define PG8_SB(b, h) ((4 + (b) * 2 + (h)) * HTB)
#define PG8_STAGE(bufoff, gbase, voff) do { _Pragma("unroll") for (int _i = 0; _i < 2; ++_i) \
        __builtin_amdgcn_global_load_lds((const unsigned*)((const char*)(gbase) + (voff)[_i]), (PG8_LAS unsigned*)(lds + (bufoff) + ldsw + _i * 8192), 16, 0, 0); } while (0)
#define PG8_LDA(dst, b, h) do { _Pragma("unroll") for (int m = 0; m < 4; ++m) _Pragma("unroll") for (int k = 0; k < 2; ++k) dst[m][k] = *(const PG8_LAS bf16x8*)(lds + PG8_SA(b, h) + aoff + m * 2048 + k * 1024); } while (0)
#define PG8_LDB(dst, b, h) do { _Pragma("unroll") for (int n = 0; n < 2; ++n) _Pragma("unroll") for (int k = 0; k < 2; ++k) dst[n][k] = *(const PG8_LAS bf16x8*)(lds + PG8_SB(b, h) + boff + n * 2048 + k * 1024); } while (0)
#define PG8_MMA(ai, bj, At, Bt) do { __builtin_amdgcn_s_setprio(1); _Pragma("unroll") for (int m = 0; m < 4; ++m) _Pragma("unroll") for (int n = 0; n < 2; ++n) _Pragma("unroll") for (int k = 0; k < 2; ++k) \
        acc[ai][bj][m][n] = __builtin_amdgcn_mfma_f32_16x16x32_bf16(Bt[n][k], At[m][k], acc[ai][bj][m][n], 0, 0, 0); __builtin_amdgcn_s_setprio(0); } while (0)
#define PG8_WAIT_V(n) asm volatile("s_waitcnt vmcnt(" #n ")" ::: "memory")
#define PG8_WAIT_L(n) asm volatile("s_waitcnt lgkmcnt(" #n ")" ::: "memory")
#define PG8_BAR __builtin_amdgcn_s_barrier()
#define PG8_SCHED __builtin_amdgcn_sched_barrier(0)
    Unit cur, nxt; int ui = 0;
    if (!S.next(0, cur)) return;
    f32x4 acc[2][2][4][2];
#pragma unroll
    for (int a = 0; a < 2; ++a)
#pragma unroll
        for (int b = 0; b < 2; ++b)
#pragma unroll
            for (int m = 0; m < 4; ++m)
#pragma unroll
                for (int n = 0; n < 2; ++n) acc[a][b][m][n] = (f32x4){0.f, 0.f, 0.f, 0.f};
    bf16x8 At[4][2], B0[2][2], B1[2][2];
    const char* cA = (const char*)g.A + (size_t)cur.pm * tstep; const char* cB = (const char*)g.Bt + (size_t)cur.pn * tstep;
    S.a_ready(cur);
    PG8_STAGE(PG8_SB(0, 0), cB, voffB); PG8_STAGE(PG8_SA(0, 0), cA, voffA); PG8_STAGE(PG8_SB(0, 1), cB + hstep, voffB); PG8_STAGE(PG8_SA(0, 1), cA + hstep, voffA);
    if (wr == 1) PG8_BAR;
    PG8_WAIT_V(4); PG8_BAR;
    PG8_STAGE(PG8_SB(1, 0), cB + kstep, voffB); PG8_STAGE(PG8_SA(1, 0), cA + kstep, voffA); PG8_STAGE(PG8_SB(1, 1), cB + hstep + kstep, voffB);
    PG8_WAIT_V(6); PG8_BAR;
    PG8_STAMP();
    for (;;) {
        const bool has_next = S.next(ui + 1, nxt);
        const char* nA = has_next ? (const char*)g.A + (size_t)nxt.pm * tstep : cA; const char* nB = has_next ? (const char*)g.Bt + (size_t)nxt.pn * tstep : cB;
        for (int t = 0; t < nt; t += 2) {
            const bool last = (t == nt - 2);
            const char* a1 = cA + (size_t)(t + 1) * kstep;
            const char* a2 = last ? nA : cA + (size_t)(t + 2) * kstep; const char* b2 = last ? nB : cB + (size_t)(t + 2) * kstep;
            const char* a3 = a2 + kstep; const char* b3 = b2 + kstep;
            if (last && has_next) S.a_ready(nxt);
            PG8_LDB(B0, 0, 0); PG8_SCHED; PG8_LDA(At, 0, 0); PG8_STAGE(PG8_SA(1, 1), a1 + hstep, voffA);
            PG8_WAIT_L(8); PG8_BAR; PG8_WAIT_L(0); PG8_MMA(0, 0, At, B0); PG8_BAR; PG8_SCHED;
            PG8_LDB(B1, 0, 1); PG8_STAGE(PG8_SB(0, 0), b2, voffB);
            PG8_BAR; PG8_WAIT_L(0); PG8_MMA(0, 1, At, B1); PG8_BAR;
            PG8_LDA(At, 0, 1); PG8_STAGE(PG8_SA(0, 0), a2, voffA);
            PG8_BAR; PG8_WAIT_L(0); PG8_MMA(1, 0, At, B0); PG8_BAR; PG8_SCHED;
            PG8_STAGE(PG8_SB(0, 1), b2 + hstep, voffB);
            PG8_WAIT_V(6); PG8_BAR; PG8_MMA(1, 1, At, B1); PG8_BAR;
            PG8_LDB(B0, 1, 0); PG8_SCHED; PG8_LDA(At, 1, 0); PG8_STAGE(PG8_SA(0, 1), a2 + hstep, voffA);
            PG8_WAIT_L(8); PG8_BAR; PG8_WAIT_L(0); PG8_MMA(0, 0, At, B0); PG8_BAR; PG8_SCHED;
            PG8_LDB(B1, 1, 1); PG8_STAGE(PG8_SB(1, 0), b3, voffB);
            PG8_BAR; PG8_WAIT_L(0); PG8_MMA(0, 1, At, B1); PG8_BAR;
            PG8_LDA(At, 1, 1); PG8_STAGE(PG8_SA(1, 0), a3, voffA);
            PG8_BAR; PG8_WAIT_L(0); PG8_MMA(1, 0, At, B0); PG8_BAR; PG8_SCHED;
            PG8_STAGE(PG8_SB(1, 1), b3 + hstep, voffB);
            PG8_WAIT_V(6); PG8_BAR; PG8_MMA(1, 1, At, B1); PG8_BAR;
        }
        PG8_STAMP();
        if constexpr (!Epi::AFTER_DRAIN) { E(acc, cur, wr, wc, fr, fq); S.done(cur); }
        PG8_STAMP();
        if (!has_next) break;
#pragma unroll
        for (int a = 0; a < 2; ++a)
#pragma unroll
            for (int b = 0; b < 2; ++b)
#pragma unroll
                for (int m = 0; m < 4; ++m)
#pragma unroll
                    for (int n = 0; n < 2; ++n) acc[a][b][m][n] = (f32x4){0.f, 0.f, 0.f, 0.f};
        cur = nxt; cA = nA; cB = nB; ++ui;
    }
    PG8_WAIT_V(0);
    if (wr == 0) PG8_BAR;
    PG8_BAR;
    if constexpr (Epi::AFTER_DRAIN) { E.fused(acc, cur, wr, wc, fr, fq, lds, wid, lane); S.done(cur); }
    PG8_STAMP();
    if (STAMP && wid == 0) { stamps[lane] = lane < nts ? (((unsigned long long)(unsigned)ts_hi << 32) | (unsigned)ts_lo) : 0ull;
        if (lane == 62) stamps[62] = rt_entry; if (lane == 63) stamps[63] = (unsigned long long)wall_clock64(); }
#undef PG8_STAMP
#undef PG8_SA
#undef PG8_SB
#undef PG8_STAGE
#undef PG8_LDA
#undef PG8_LDB
#undef PG8_MMA
#undef PG8_WAIT_V
#undef PG8_WAIT_L
#undef PG8_BAR
#undef PG8_SCHED
}
}
#define LAS __attribute__((address_space(3)))
typedef unsigned short bf16;
typedef float f32x4 __attribute__((ext_vector_type(4)));
typedef short bf16x8 __attribute__((ext_vector_type(8)));
typedef short bf16x4 __attribute__((ext_vector_type(4)));
typedef unsigned u32x4 __attribute__((ext_vector_type(4)));
typedef unsigned u32x2 __attribute__((ext_vector_type(2)));
constexpr int NB = 8, SEQ = 4096, DM = 1024, MT = NB * SEQ;
constexpr int NIN = 3592, NPROJ = 3584, FF = 4096, PLE = 256;
constexpr int C_AQ = 0, C_AK = 512, C_AV = 1024, C_MQ = 1536, C_MK = 2048, C_MV = 2560, C_MO = 3072;
constexpr size_t MiB = 1u << 20;
constexpr size_t WS_WIN = 0, WS_WOUT = 7 * MiB, WS_WUP = 9 * MiB, WS_WDN = 17 * MiB, WS_WPG = 25 * MiB, WS_WPLE = 27 * MiB;
constexpr size_t WS_PB = 28 * MiB;
constexpr size_t WS_GATES = 44 * MiB;
constexpr size_t WS_SA = 45 * MiB, WS_SR = WS_SA + 512 * 1024, WS_SB = 46 * MiB, WS_SMC = WS_SB + 512 * 1024;
constexpr size_t WS_ROPE = 47 * MiB;
constexpr size_t WS_LSE = 48 * MiB;
constexpr size_t WS_NS = 51 * MiB;
constexpr size_t WS_SSQ1 = 52 * MiB, WS_SSQ2 = 54 * MiB, WS_SSQ3 = 56 * MiB;
constexpr size_t WS_BUFA = 64 * MiB;
constexpr size_t WS_BUFB = 128 * MiB;
constexpr size_t WS_PROJ = 192 * MiB;
constexpr size_t WS_OP = 416 * MiB;
constexpr size_t WS_ACT = 192 * MiB;
constexpr size_t WS_END = 512 * MiB;
constexpr int LDS_BYTES = 135168;

__device__ __forceinline__ unsigned f2bf(float f) { unsigned u = __builtin_bit_cast(unsigned, f); return (u + 0x7fffu + ((u >> 16) & 1u)) >> 16; }
__device__ __forceinline__ unsigned pk2(float lo, float hi) { return f2bf(lo) | (f2bf(hi) << 16); }
__device__ __forceinline__ float bflo(unsigned w) { return __builtin_bit_cast(float, w << 16); }
__device__ __forceinline__ float bfhi(unsigned w) { return __builtin_bit_cast(float, w & 0xffff0000u); }
__device__ __forceinline__ float wave_sum(float v) {
#pragma unroll
    for (int o = 32; o >= 1; o >>= 1) v += __shfl_xor(v, o);
    return v; }
#define MFMA16(a, b, c) __builtin_amdgcn_mfma_f32_16x16x32_bf16((a), (b), (c), 0, 0, 0)

struct Params { const float* in[16]; float* out; unsigned char* ws; int ph_lo, ph_hi; };

__device__ __forceinline__ void transpose_item(const float* W, int Nsrc, int K, const float* g, bf16* Wt, int k0, int n0, LAS float* tile) {
    const int tid = threadIdx.x;
#pragma unroll
    for (int pass = 0; pass < 2; ++pass) {
        const int kk = (tid >> 4) + pass * 32, nn = (tid & 15) * 4;
        const f32x4 v = *(const f32x4*)(W + (size_t)(k0 + kk) * Nsrc + n0 + nn);
        const float gs = g ? g[k0 + kk] : 1.0f;
        tile[kk * 65 + nn + 0] = v[0] * gs; tile[kk * 65 + nn + 1] = v[1] * gs; tile[kk * 65 + nn + 2] = v[2] * gs; tile[kk * 65 + nn + 3] = v[3] * gs;
    }
    __syncthreads();
    { const int n = tid >> 3, kc = (tid & 7) * 8; u32x4 w;
      w.x = pk2(tile[(kc + 0) * 65 + n], tile[(kc + 1) * 65 + n]); w.y = pk2(tile[(kc + 2) * 65 + n], tile[(kc + 3) * 65 + n]);
      w.z = pk2(tile[(kc + 4) * 65 + n], tile[(kc + 5) * 65 + n]); w.w = pk2(tile[(kc + 6) * 65 + n], tile[(kc + 7) * 65 + n]);
      *(u32x4*)(Wt + (size_t)(n0 + n) * K + k0 + kc) = w; }
    __syncthreads();
}
__device__ __forceinline__ void p0_prologue(const Params& P, LAS unsigned char* lds) {
    const int tid = threadIdx.x, lane = tid & 63, wave = tid >> 6, G = gridDim.x, bx = blockIdx.x;
    unsigned char* ws = P.ws;
    LAS float* tile = (LAS float*)lds;
    LAS float* wg = (LAS float*)(lds + 32768);
    { const float* w_in = P.in[3]; const float* gm = P.in[2];
      for (int i = tid; i < 8192; i += 512) { const int k = i >> 3, j = i & 7; wg[j * 1024 + k] = w_in[(size_t)k * NIN + NPROJ + j] * gm[k]; } }
    { constexpr int I_IN = 16 * 56, I_OUT = 16 * 16, I_UP = 16 * 64, I_DN = 64 * 16, I_PG = 16 * 16, I_PLE = 4 * 16;
      constexpr int NIT = I_IN + I_OUT + I_UP + I_DN + I_PG + I_PLE;
      for (int it = bx; it < NIT; it += G) {
          int r = it;
          if (r < I_IN) { transpose_item(P.in[3], NIN, 1024, nullptr, (bf16*)(ws + WS_WIN), (r & 15) * 64, (r >> 4) * 64, tile); continue; } r -= I_IN;
          if (r < I_OUT) { transpose_item(P.in[8], 1024, 1024, nullptr, (bf16*)(ws + WS_WOUT), (r & 15) * 64, (r >> 4) * 64, tile); continue; } r -= I_OUT;
          if (r < I_UP) { transpose_item(P.in[10], 4096, 1024, P.in[9], (bf16*)(ws + WS_WUP), (r & 15) * 64, (r >> 4) * 64, tile); continue; } r -= I_UP;
          if (r < I_DN) { transpose_item(P.in[11], 1024, 4096, nullptr, (bf16*)(ws + WS_WDN), (r & 63) * 64, (r >> 6) * 64, tile); continue; } r -= I_DN;
          if (r < I_PG) { transpose_item(P.in[13], 1024, 1024, P.in[12], (bf16*)(ws + WS_WPG), (r & 15) * 64, (r >> 4) * 64, tile); continue; } r -= I_PG;
          transpose_item(P.in[14], 1024, 256, nullptr, (bf16*)(ws + WS_WPLE), (r & 3) * 64, (r >> 2) * 64, tile);
      } }
    __syncthreads();
    { const float* x = P.in[0]; const float* gm = P.in[2]; const float* gate_b = P.in[6];
      bf16* U = (bf16*)(ws + WS_BUFA); float* GT = (float*)(ws + WS_GATES);
      f32x4 gv[4];
#pragma unroll
      for (int j = 0; j < 4; ++j) gv[j] = ((const f32x4*)gm)[lane + 64 * j];
      const float gb = gate_b[lane & 7];
      for (int row = bx * 8 + wave; row < MT; row += G * 8) {
          f32x4 xv[4]; float ss = 0.f;
#pragma unroll
          for (int j = 0; j < 4; ++j) { xv[j] = ((const f32x4*)(x + (size_t)row * DM))[lane + 64 * j]; ss += (xv[j][0] * xv[j][0] + xv[j][1] * xv[j][1]) + (xv[j][2] * xv[j][2] + xv[j][3] * xv[j][3]); }
          ss = wave_sum(ss);
          const float rs = 1.0f / sqrtf(ss * (1.0f / DM) + 1e-6f);
#pragma unroll
          for (int j = 0; j < 4; ++j) { const f32x4 o = xv[j] * rs * gv[j]; u32x2 w; w.x = pk2(o[0], o[1]); w.y = pk2(o[2], o[3]);
              *(u32x2*)(U + (size_t)row * DM + (lane + 64 * j) * 4) = w; }
          float myg = 0.f;
#pragma unroll
          for (int gj = 0; gj < 8; ++gj) { float a = 0.f;
#pragma unroll
              for (int j = 0; j < 4; ++j) { const f32x4 wv = ((const LAS f32x4*)(wg + gj * 1024))[lane + 64 * j]; a += (xv[j][0] * wv[0] + xv[j][1] * wv[1]) + (xv[j][2] * wv[2] + xv[j][3] * wv[3]); }
              a = wave_sum(a); if ((lane & 7) == gj) myg = a; }
          if (lane < 8) GT[(size_t)row * 8 + lane] = myg * rs + gb;
      } }
    { const f32x4* p4 = (const f32x4*)P.in[1]; u32x2* pb = (u32x2*)(ws + WS_PB);
      for (size_t i = (size_t)bx * 512 + tid; i < (size_t)MT * PLE / 4; i += (size_t)G * 512) { const f32x4 v = p4[i]; u32x2 w; w.x = pk2(v[0], v[1]); w.y = pk2(v[2], v[3]); pb[i] = w; } }
    { float* rc = (float*)(ws + WS_ROPE); float* rsn = rc + 4096 * 8;
      for (int i = bx * 512 + tid; i < 4096 * 8; i += G * 512) { const int pos = i >> 3, f = i & 7; const float inv = powf(500000.0f, -(float)f * 0.125f); const float ang = (float)pos * inv;
          rc[i] = cosf(ang); rsn[i] = sinf(ang); } }
}

__device__ __forceinline__ void gate_scan(const Params& P, int bh, LAS unsigned char* lds) {
    const int tid = threadIdx.x, lane = tid & 63, wave = tid >> 6; const int b = bh >> 2, h = bh & 3;
    unsigned char* ws = P.ws; const float* GT = (const float*)(ws + WS_GATES);
    float* SA = (float*)(ws + WS_SA); float* SR = (float*)(ws + WS_SR); float* SB = (float*)(ws + WS_SB); float* SMC = (float*)(ws + WS_SMC);
    LAS float* sm = (LAS float*)lds;
    float a_[8], b_[8], cm_[8];
#pragma unroll
    for (int j = 0; j < 8; ++j) { const int c = wave + 8 * j, t = c * 64 + lane; const float* gp = GT + (size_t)(b * SEQ + t) * 8;
        const float ip = gp[h], fp = gp[4 + h];
        const float lf = fminf(fp, 0.f) - log1pf(expf(-fabsf(fp)));
        float s = lf;
#pragma unroll
        for (int o = 1; o < 64; o <<= 1) { const float v = __shfl_up(s, o); if (lane >= o) s += v; }
        const float a = ip - s; float cm = a;
#pragma unroll
        for (int o = 1; o < 64; o <<= 1) { const float v = __shfl_up(cm, o); if (lane >= o) cm = fmaxf(cm, v); }
        a_[j] = a; b_[j] = s; cm_[j] = cm;
        if (lane == 63) { sm[c] = s; sm[64 + c] = cm; } }
    __syncthreads();
    if (tid == 0) { float m = 0.f; for (int c = 0; c < 64; ++c) { sm[128 + c] = m; m = sm[c] + fmaxf(m, sm[64 + c]); } }
    __syncthreads();
#pragma unroll
    for (int j = 0; j < 8; ++j) { const int c = wave + 8 * j, t = c * 64 + lane; const float mc = sm[128 + c];
        SA[bh * SEQ + t] = a_[j]; SR[bh * SEQ + t] = fmaxf(mc, cm_[j]); SB[bh * SEQ + t] = b_[j]; if (lane == 0) SMC[bh * 64 + c] = mc; }
    __syncthreads();
}

__device__ __forceinline__ void rope16(u32x4& lo, u32x4& hi, const float* rc, const float* rsn, int pos) {
    const f32x4 c0 = *(const f32x4*)(rc + pos * 8), c1 = *(const f32x4*)(rc + pos * 8 + 4), s0 = *(const f32x4*)(rsn + pos * 8), s1 = *(const f32x4*)(rsn + pos * 8 + 4);
    float x1[8] = {bflo(lo.x), bfhi(lo.x), bflo(lo.y), bfhi(lo.y), bflo(lo.z), bfhi(lo.z), bflo(lo.w), bfhi(lo.w)};
    float x2[8] = {bflo(hi.x), bfhi(hi.x), bflo(hi.y), bfhi(hi.y), bflo(hi.z), bfhi(hi.z), bflo(hi.w), bfhi(hi.w)};
    float cc[8] = {c0[0], c0[1], c0[2], c0[3], c1[0], c1[1], c1[2], c1[3]}, sn[8] = {s0[0], s0[1], s0[2], s0[3], s1[0], s1[1], s1[2], s1[3]};
    float y1[8], y2[8];
#pragma unroll
    for (int i = 0; i < 8; ++i) { y1[i] = x1[i] * cc[i] - x2[i] * sn[i]; y2[i] = x2[i] * cc[i] + x1[i] * sn[i]; }
    lo.x = pk2(y1[0], y1[1]); lo.y = pk2(y1[2], y1[3]); lo.z = pk2(y1[4], y1[5]); lo.w = pk2(y1[6], y1[7]);
    hi.x = pk2(y2[0], y2[1]); hi.y = pk2(y2[2], y2[3]); hi.z = pk2(y2[4], y2[5]); hi.w = pk2(y2[6], y2[7]);
}
constexpr int AQ_STRIDE = 144, AV_STRIDE = 528;
constexpr int A_QOFF = 0, A_KOFF = 128 * AQ_STRIDE, A_VOFF = A_KOFF + 256 * AQ_STRIDE;
__device__ __forceinline__ void attn_item(const Params& P, int item, LAS unsigned char* lds) {
    const int tid = threadIdx.x, lane = tid & 63, wave = tid >> 6, fr = lane & 15, g = lane >> 4;
    unsigned char* ws = P.ws; const bf16* proj = (const bf16*)(ws + WS_PROJ);
    const float* rc = (const float*)(ws + WS_ROPE); const float* rsn = rc + 4096 * 8;
    const int pi = item >> 11, rem = item & 2047, bh = rem >> 5, jj = rem & 31, b = bh >> 3, h = bh & 7;
    const int dsh = 2 * pi, nbsh = 5 - 2 * pi;
    const int r = jj >> nbsh, n = jj & ((1 << nbsh) - 1);
    const size_t tokbase = (size_t)b * SEQ;
    { const int qi = tid >> 2, dc = tid & 3; const int pos = ((n * 128 + qi) << dsh) + r;
      const bf16* src = proj + (tokbase + pos) * NPROJ + C_AQ + h * 64 + dc * 16;
      u32x4 lo = *(const u32x4*)src, hi = *(const u32x4*)(src + 8);
      if (dc == 0) rope16(lo, hi, rc, rsn, pos);
      *(LAS u32x4*)(lds + A_QOFF + qi * AQ_STRIDE + dc * 32) = lo; *(LAS u32x4*)(lds + A_QOFF + qi * AQ_STRIDE + dc * 32 + 16) = hi; }
#pragma unroll
    for (int i = 0; i < 2; ++i) { const int task = tid + 512 * i, ki = task >> 2, dc = task & 3; const int l = (n - 1) * 128 + ki;
        u32x4 lo = (u32x4){0u, 0u, 0u, 0u}, hi = lo;
        if (l >= 0) { const int pos = (l << dsh) + r; const bf16* src = proj + (tokbase + pos) * NPROJ + C_AK + h * 64 + dc * 16;
            lo = *(const u32x4*)src; hi = *(const u32x4*)(src + 8); if (dc == 0) rope16(lo, hi, rc, rsn, pos); }
        *(LAS u32x4*)(lds + A_KOFF + ki * AQ_STRIDE + dc * 32) = lo; *(LAS u32x4*)(lds + A_KOFF + ki * AQ_STRIDE + dc * 32 + 16) = hi; }
#pragma unroll
    for (int i = 0; i < 2; ++i) { const int task = tid + 512 * i, kp = task & 127, dg = task >> 7; const int l0 = (n - 1) * 128 + 2 * kp;
        u32x4 va = (u32x4){0u, 0u, 0u, 0u}, vb = va;
        if (l0 >= 0) { const int p0 = (l0 << dsh) + r, p1 = ((l0 + 1) << dsh) + r;
            va = *(const u32x4*)(proj + (tokbase + p0) * NPROJ + C_AV + h * 64 + dg * 8); vb = *(const u32x4*)(proj + (tokbase + p1) * NPROJ + C_AV + h * 64 + dg * 8); }
        LAS unsigned char* vt = lds + A_VOFF + (dg * 8) * AV_STRIDE + kp * 4;
        *(LAS unsigned*)(vt + 0 * AV_STRIDE) = (va.x & 0xffffu) | (vb.x << 16); *(LAS unsigned*)(vt + 1 * AV_STRIDE) = (va.x >> 16) | (vb.x & 0xffff0000u);
        *(LAS unsigned*)(vt + 2 * AV_STRIDE) = (va.y & 0xffffu) | (vb.y << 16); *(LAS unsigned*)(vt + 3 * AV_STRIDE) = (va.y >> 16) | (vb.y & 0xffff0000u);
        *(LAS unsigned*)(vt + 4 * AV_STRIDE) = (va.z & 0xffffu) | (vb.z << 16); *(LAS unsigned*)(vt + 5 * AV_STRIDE) = (va.z >> 16) | (vb.z & 0xffff0000u);
        *(LAS unsigned*)(vt + 6 * AV_STRIDE) = (va.w & 0xffffu) | (vb.w << 16); *(LAS unsigned*)(vt + 7 * AV_STRIDE) = (va.w >> 16) | (vb.w & 0xffff0000u); }
    __syncthreads();
    const int q0 = wave * 16;
    bf16x8 qf[2];
#pragma unroll
    for (int ks = 0; ks < 2; ++ks) qf[ks] = *(const LAS bf16x8*)(lds + A_QOFF + (q0 + fr) * AQ_STRIDE + ks * 64 + g * 16);
    f32x4 sc[9];
#pragma unroll
    for (int nt = 0; nt < 9; ++nt) { f32x4 a = (f32x4){0.f, 0.f, 0.f, 0.f};
#pragma unroll
        for (int ks = 0; ks < 2; ++ks) { const bf16x8 kf = *(const LAS bf16x8*)(lds + A_KOFF + (q0 + 16 * nt + fr) * AQ_STRIDE + ks * 64 + g * 16); a = MFMA16(kf, qf[ks], a); }
        sc[nt] = a; }
    const float SC2 = 0.125f * 1.4426950408889634f;
    float mx = -INFINITY;
#pragma unroll
    for (int nt = 0; nt < 9; ++nt)
#pragma unroll
        for (int i = 0; i < 4; ++i) { const int rel = 16 * nt + 4 * g + i - fr; const bool ok = (rel >= 0) && (rel <= 128) && (n > 0 || (q0 + 16 * nt + 4 * g + i) >= 128);
            const float s = ok ? sc[nt][i] * SC2 : -INFINITY; sc[nt][i] = s; mx = fmaxf(mx, s); }
    mx = fmaxf(mx, __shfl_xor(mx, 16)); mx = fmaxf(mx, __shfl_xor(mx, 32));
    float den = 0.f;
#pragma unroll
    for (int nt = 0; nt < 9; ++nt)
#pragma unroll
        for (int i = 0; i < 4; ++i) { const float p = __builtin_amdgcn_exp2f(sc[nt][i] - mx); sc[nt][i] = p; den += p; }
    den += __shfl_xor(den, 16); den += __shfl_xor(den, 32);
    bf16x8 pf[5];
#pragma unroll
    for (int ks = 0; ks < 5; ++ks) { u32x4 w; w.x = pk2(sc[2 * ks][0], sc[2 * ks][1]); w.y = pk2(sc[2 * ks][2], sc[2 * ks][3]);
        if (ks < 4) { w.z = pk2(sc[2 * ks + 1][0], sc[2 * ks + 1][1]); w.w = pk2(sc[2 * ks + 1][2], sc[2 * ks + 1][3]); } else { w.z = 0u; w.w = 0u; }
        pf[ks] = __builtin_bit_cast(bf16x8, w); }
    const float inv = 1.0f / den;
    const int posq = ((n * 128 + q0 + fr) << dsh) + r;
    bf16* OP = (bf16*)(ws + WS_OP) + (size_t)pi * MT * 512 + (tokbase + posq) * 512 + h * 64;
#pragma unroll
    for (int et = 0; et < 4; ++et) { f32x4 o = (f32x4){0.f, 0.f, 0.f, 0.f};
#pragma unroll
        for (int ks = 0; ks < 5; ++ks) { const LAS unsigned char* vp = lds + A_VOFF + (et * 16 + fr) * AV_STRIDE + (q0 + 32 * ks + 4 * g) * 2;
            const u32x2 v0 = *(const LAS u32x2*)vp; u32x2 v1 = (u32x2){0u, 0u}; if (ks < 4) v1 = *(const LAS u32x2*)(vp + 32);
            const u32x4 vw = (u32x4){v0.x, v0.y, v1.x, v1.y};
            o = MFMA16(__builtin_bit_cast(bf16x8, vw), pf[ks], o); }
        u32x2 w; w.x = pk2(o[0] * inv, o[1] * inv); w.y = pk2(o[2] * inv, o[3] * inv);
        *(u32x2*)(OP + et * 16 + 4 * g) = w; }
    if (g == 0) ((float*)(ws + WS_LSE))[(size_t)pi * MT * 8 + (tokbase + posq) * 8 + h] = mx * 0.6931471805599453f + logf(den);
    __syncthreads();
}

__device__ __forceinline__ void conv_silu2(const u32x4 (&xr)[5], const float* cw  , const float* cb, int ch, float scale, float (&o0)[8], float (&o1)[8]) {
    float xv[5][8];
#pragma unroll
    for (int i = 0; i < 5; ++i) { xv[i][0] = bflo(xr[i].x); xv[i][1] = bfhi(xr[i].x); xv[i][2] = bflo(xr[i].y); xv[i][3] = bfhi(xr[i].y); xv[i][4] = bflo(xr[i].z); xv[i][5] = bfhi(xr[i].z); xv[i][6] = bflo(xr[i].w); xv[i][7] = bfhi(xr[i].w); }
    float wv[4][8], bv[8];
#pragma unroll
    for (int j = 0; j < 4; ++j) { const f32x4 a = *(const f32x4*)(cw + j * 1024 + ch), c = *(const f32x4*)(cw + j * 1024 + ch + 4);
        wv[j][0] = a[0]; wv[j][1] = a[1]; wv[j][2] = a[2]; wv[j][3] = a[3]; wv[j][4] = c[0]; wv[j][5] = c[1]; wv[j][6] = c[2]; wv[j][7] = c[3]; }
    { const f32x4 a = *(const f32x4*)(cb + ch), c = *(const f32x4*)(cb + ch + 4); bv[0] = a[0]; bv[1] = a[1]; bv[2] = a[2]; bv[3] = a[3]; bv[4] = c[0]; bv[5] = c[1]; bv[6] = c[2]; bv[7] = c[3]; }
#pragma unroll
    for (int e = 0; e < 8; ++e) {
        float s0 = bv[e], s1 = bv[e];
#pragma unroll
        for (int j = 0; j < 4; ++j) { s0 += wv[j][e] * xv[j][e]; s1 += wv[j][e] * xv[j + 1][e]; }
        o0[e] = s0 / (1.0f + __expf(-s0)) * scale; o1[e] = s1 / (1.0f + __expf(-s1)) * scale; }
}
__device__ __forceinline__ void load5(const bf16* proj, int b, int t0, int col, u32x4 (&xr)[5]) {
#pragma unroll
    for (int i = 0; i < 5; ++i) { const int t = t0 - 3 + i; xr[i] = (u32x4){0u, 0u, 0u, 0u};
        if (t >= 0) xr[i] = *(const u32x4*)(proj + ((size_t)b * SEQ + t) * NPROJ + col); }
}
constexpr int T72 = 144, T136 = 272;
__device__ __forceinline__ void stage_vt(const bf16* proj, int b, int h, int t0, LAS unsigned char* vt) {
    const int tid = threadIdx.x, eg = tid >> 5, tg = tid & 31;
    const bf16* s0 = proj + ((size_t)b * SEQ + t0 + 2 * tg) * NPROJ + C_MV + h * 128 + eg * 8;
    const u32x4 va = *(const u32x4*)s0, vb = *(const u32x4*)(s0 + NPROJ);
    LAS unsigned char* d = vt + (eg * 8) * T72 + tg * 4;
    *(LAS unsigned*)(d + 0 * T72) = (va.x & 0xffffu) | (vb.x << 16); *(LAS unsigned*)(d + 1 * T72) = (va.x >> 16) | (vb.x & 0xffff0000u);
    *(LAS unsigned*)(d + 2 * T72) = (va.y & 0xffffu) | (vb.y << 16); *(LAS unsigned*)(d + 3 * T72) = (va.y >> 16) | (vb.y & 0xffff0000u);
    *(LAS unsigned*)(d + 4 * T72) = (va.z & 0xffffu) | (vb.z << 16); *(LAS unsigned*)(d + 5 * T72) = (va.z >> 16) | (vb.z & 0xffff0000u);
    *(LAS unsigned*)(d + 6 * T72) = (va.w & 0xffffu) | (vb.w << 16); *(LAS unsigned*)(d + 7 * T72) = (va.w >> 16) | (vb.w & 0xffff0000u);
}

__device__ __forceinline__ void mlstm_local_item(const Params& P, int item, LAS unsigned char* lds) {
    const int tid = threadIdx.x, lane = tid & 63, wave = tid >> 6, fr = lane & 15, g = lane >> 4;
    const int bh = item >> 6, c = item & 63, b = bh >> 2, h = bh & 3;
    if (c == 63) return;
    unsigned char* ws = P.ws; const bf16* proj = (const bf16*)(ws + WS_PROJ);
    const float* SA = (const float*)(ws + WS_SA); const float* SR = (const float*)(ws + WS_SR);
    LAS unsigned char* kwt = lds; LAS unsigned char* vt = lds + 128 * T72;
    const int t0 = c * 64;
    { const int cgp = tid >> 5, tg = tid & 31; u32x4 xr[5]; load5(proj, b, t0 + 2 * tg, C_MK + h * 128 + cgp * 8, xr);
      float o0[8], o1[8]; conv_silu2(xr, P.in[4], P.in[5], 512 + h * 128 + cgp * 8, 0.08838834764831845f, o0, o1);
      const float rl = SR[bh * SEQ + t0 + 63]; const float w0 = __expf(SA[bh * SEQ + t0 + 2 * tg] - rl), w1 = __expf(SA[bh * SEQ + t0 + 2 * tg + 1] - rl);
      LAS unsigned char* d = kwt + (cgp * 8) * T72 + tg * 4;
#pragma unroll
      for (int e = 0; e < 8; ++e) *(LAS unsigned*)(d + e * T72) = pk2(o0[e] * w0, o1[e] * w1); }
    stage_vt(proj, b, h, t0, vt);
    __syncthreads();
    if (tid < 128) { float s = 0.f;
#pragma unroll
        for (int q = 0; q < 8; ++q) { const u32x4 w = *(const LAS u32x4*)(kwt + tid * T72 + q * 16); s += (bflo(w.x) + bfhi(w.x)) + (bflo(w.y) + bfhi(w.y)) + (bflo(w.z) + bfhi(w.z)) + (bflo(w.w) + bfhi(w.w)); }
        ((float*)(ws + WS_NS))[(size_t)item * 128 + tid] = s; }
    bf16x8 vf[2];
#pragma unroll
    for (int ks = 0; ks < 2; ++ks) vf[ks] = *(const LAS bf16x8*)(vt + (wave * 16 + fr) * T72 + ks * 64 + g * 16);
    bf16* ST = (bf16*)(ws + WS_BUFB) + (size_t)item * 16384 + (wave * 16 + fr) * 128;
#pragma unroll
    for (int dt = 0; dt < 8; ++dt) { f32x4 a = (f32x4){0.f, 0.f, 0.f, 0.f};
#pragma unroll
        for (int ks = 0; ks < 2; ++ks) { const bf16x8 kf = *(const LAS bf16x8*)(kwt + (dt * 16 + fr) * T72 + ks * 64 + g * 16); a = MFMA16(kf, vf[ks], a); }
        u32x2 w; w.x = pk2(a[0], a[1]); w.y = pk2(a[2], a[3]);
        *(u32x2*)(ST + dt * 16 + 4 * g) = w; }
    __syncthreads();
}

__device__ __forceinline__ void mlstm_scan(const Params& P) {
    unsigned char* ws = P.ws; const float* SR = (const float*)(ws + WS_SR); const float* SMC = (const float*)(ws + WS_SMC);
    const int G = gridDim.x;
    for (int gid = blockIdx.x * 512 + threadIdx.x; gid < 32 * 4096; gid += G * 512) {
        const int bh = gid >> 12, off = (gid & 4095) * 4;
        u32x2* st = (u32x2*)((bf16*)(ws + WS_BUFB) + (size_t)bh * 64 * 16384 + off);
        float s0 = 0.f, s1 = 0.f, s2 = 0.f, s3 = 0.f;
        for (int cb = 0; cb < 63; cb += 9) {
            u32x2 u[9]; float dc[9];
#pragma unroll
            for (int q = 0; q < 9; ++q) { u[q] = st[(size_t)(cb + q) * 4096]; dc[q] = __expf(SMC[bh * 64 + cb + q] - SR[bh * SEQ + (cb + q) * 64 + 63]); }
#pragma unroll
            for (int q = 0; q < 9; ++q) { s0 = dc[q] * s0 + bflo(u[q].x); s1 = dc[q] * s1 + bfhi(u[q].x); s2 = dc[q] * s2 + bflo(u[q].y); s3 = dc[q] * s3 + bfhi(u[q].y);
                u32x2 w; w.x = pk2(s0, s1); w.y = pk2(s2, s3); st[(size_t)(cb + q) * 4096] = w; }
        }
    }
    for (int gid = blockIdx.x * 512 + threadIdx.x; gid < 32 * 128; gid += G * 512) {
        const int bh = gid >> 7, d = gid & 127; float* ns = (float*)(ws + WS_NS) + (size_t)bh * 64 * 128 + d; float s = 0.f;
        for (int c = 0; c < 63; ++c) { const float dc = __expf(SMC[bh * 64 + c] - SR[bh * SEQ + c * 64 + 63]); s = dc * s + ns[c * 128]; ns[c * 128] = s; }
    }
}

constexpr int M_QOFF = 0, M_KOFF = 64 * T136, M_VOFF = 2 * 64 * T136, M_COFF = M_VOFF + 128 * T72, M_NOFF = M_COFF + 128 * T136, M_SOFF = M_NOFF + 512;
__device__ __forceinline__ void mlstm_out_item(const Params& P, int item, LAS unsigned char* lds) {
    const int tid = threadIdx.x, lane = tid & 63, wave = tid >> 6, fr = lane & 15, g = lane >> 4;
    const int bh = item >> 6, c = item & 63, b = bh >> 2, h = bh & 3, t0 = c * 64;
    unsigned char* ws = P.ws; const bf16* proj = (const bf16*)(ws + WS_PROJ);
    const float* SA = (const float*)(ws + WS_SA); const float* SR = (const float*)(ws + WS_SR); const float* SB = (const float*)(ws + WS_SB); const float* SMC = (const float*)(ws + WS_SMC);
    { const int cgp = tid & 15, tg = tid >> 4; u32x4 xr[5]; float o0[8], o1[8]; u32x4 w;
      load5(proj, b, t0 + 2 * tg, C_MQ + h * 128 + cgp * 8, xr);
      conv_silu2(xr, P.in[4], P.in[5], h * 128 + cgp * 8, 1.0f, o0, o1);
      w.x = pk2(o0[0], o0[1]); w.y = pk2(o0[2], o0[3]); w.z = pk2(o0[4], o0[5]); w.w = pk2(o0[6], o0[7]); *(LAS u32x4*)(lds + M_QOFF + (2 * tg) * T136 + cgp * 16) = w;
      w.x = pk2(o1[0], o1[1]); w.y = pk2(o1[2], o1[3]); w.z = pk2(o1[4], o1[5]); w.w = pk2(o1[6], o1[7]); *(LAS u32x4*)(lds + M_QOFF + (2 * tg + 1) * T136 + cgp * 16) = w;
      load5(proj, b, t0 + 2 * tg, C_MK + h * 128 + cgp * 8, xr);
      conv_silu2(xr, P.in[4], P.in[5], 512 + h * 128 + cgp * 8, 0.08838834764831845f, o0, o1);
      w.x = pk2(o0[0], o0[1]); w.y = pk2(o0[2], o0[3]); w.z = pk2(o0[4], o0[5]); w.w = pk2(o0[6], o0[7]); *(LAS u32x4*)(lds + M_KOFF + (2 * tg) * T136 + cgp * 16) = w;
      w.x = pk2(o1[0], o1[1]); w.y = pk2(o1[2], o1[3]); w.z = pk2(o1[4], o1[5]); w.w = pk2(o1[6], o1[7]); *(LAS u32x4*)(lds + M_KOFF + (2 * tg + 1) * T136 + cgp * 16) = w; }
    stage_vt(proj, b, h, t0, lds + M_VOFF);
    { const bf16* ST = (const bf16*)(ws + WS_BUFB) + (size_t)(item - 1) * 16384;
#pragma unroll
      for (int i = 0; i < 4; ++i) { const int ch = tid + 512 * i, e = ch >> 4, q = ch & 15; u32x4 w = (u32x4){0u, 0u, 0u, 0u}; if (c > 0) w = *(const u32x4*)(ST + e * 128 + q * 8);
          *(LAS u32x4*)(lds + M_COFF + e * T136 + q * 16) = w; }
      if (tid < 128) ((LAS float*)(lds + M_NOFF))[tid] = (c > 0) ? ((const float*)(ws + WS_NS))[(size_t)(item - 1) * 128 + tid] : 0.f; }
    __syncthreads();
    const int tt = wave & 3, eh = wave >> 2, tq = tt * 16 + fr;
    bf16x8 qf[4];
#pragma unroll
    for (int ks = 0; ks < 4; ++ks) qf[ks] = *(const LAS bf16x8*)(lds + M_QOFF + tq * T136 + ks * 64 + g * 16);
    const float r_t = SR[bh * SEQ + t0 + tq], b_t = SB[bh * SEQ + t0 + tq], mc = SMC[bh * 64 + c];
    float pv[4][4]; float rsum = 0.f;
#pragma unroll
    for (int st = 0; st < 4; ++st) {
        if (st <= tt) { f32x4 a = (f32x4){0.f, 0.f, 0.f, 0.f};
#pragma unroll
            for (int ks = 0; ks < 4; ++ks) { const bf16x8 kf = *(const LAS bf16x8*)(lds + M_KOFF + (st * 16 + fr) * T136 + ks * 64 + g * 16); a = MFMA16(kf, qf[ks], a); }
            const f32x4 av = *(const f32x4*)(SA + bh * SEQ + t0 + st * 16 + 4 * g);
#pragma unroll
            for (int i = 0; i < 4; ++i) { const int s = st * 16 + 4 * g + i; const float p = (s <= tq) ? a[i] * __expf(av[i] - r_t) : 0.f; pv[st][i] = p; rsum += p; }
        } else {
#pragma unroll
            for (int i = 0; i < 4; ++i) pv[st][i] = 0.f; }
    }
    rsum += __shfl_xor(rsum, 16); rsum += __shfl_xor(rsum, 32);
    float qn = 0.f;
#pragma unroll
    for (int q = 0; q < 4; ++q) { const u32x4 w = *(const LAS u32x4*)(lds + M_QOFF + tq * T136 + g * 64 + q * 16);
        const f32x4 n0 = *(const LAS f32x4*)(lds + M_NOFF + (g * 32 + q * 8) * 4), n1 = *(const LAS f32x4*)(lds + M_NOFF + (g * 32 + q * 8 + 4) * 4);
        qn += (bflo(w.x) * n0[0] + bfhi(w.x) * n0[1]) + (bflo(w.y) * n0[2] + bfhi(w.y) * n0[3]) + (bflo(w.z) * n1[0] + bfhi(w.z) * n1[1]) + (bflo(w.w) * n1[2] + bfhi(w.w) * n1[3]); }
    qn += __shfl_xor(qn, 16); qn += __shfl_xor(qn, 32);
    const float w_inter = __expf(mc - r_t);
    const float den = w_inter * qn + rsum;
    const float idn = 1.0f / fmaxf(fabsf(den), __expf(-(b_t + r_t)));
    bf16x8 pf[2];
#pragma unroll
    for (int ks = 0; ks < 2; ++ks) { u32x4 w; w.x = pk2(pv[2 * ks][0], pv[2 * ks][1]); w.y = pk2(pv[2 * ks][2], pv[2 * ks][3]); w.z = pk2(pv[2 * ks + 1][0], pv[2 * ks + 1][1]); w.w = pk2(pv[2 * ks + 1][2], pv[2 * ks + 1][3]);
        pf[ks] = __builtin_bit_cast(bf16x8, w); }
    float hv[4][4]; float ssq = 0.f;
#pragma unroll
    for (int et = 0; et < 4; ++et) { const int e0 = eh * 64 + et * 16;
        f32x4 ag = (f32x4){0.f, 0.f, 0.f, 0.f}, ap = ag;
#pragma unroll
        for (int ks = 0; ks < 4; ++ks) { const bf16x8 cf = *(const LAS bf16x8*)(lds + M_COFF + (e0 + fr) * T136 + ks * 64 + g * 16); ag = MFMA16(cf, qf[ks], ag); }
#pragma unroll
        for (int ks = 0; ks < 2; ++ks) { const LAS unsigned char* vp = lds + M_VOFF + (e0 + fr) * T72 + (32 * ks + 4 * g) * 2;
            const u32x2 v0 = *(const LAS u32x2*)vp, v1 = *(const LAS u32x2*)(vp + 32); const u32x4 vw = (u32x4){v0.x, v0.y, v1.x, v1.y};
            ap = MFMA16(__builtin_bit_cast(bf16x8, vw), pf[ks], ap); }
#pragma unroll
        for (int i = 0; i < 4; ++i) { const float hh = (w_inter * ag[i] + ap[i]) * idn; hv[et][i] = hh; ssq += hh * hh; } }
    ssq += __shfl_xor(ssq, 16); ssq += __shfl_xor(ssq, 32);
    if (g == 0) ((LAS float*)(lds + M_SOFF))[tq * 2 + eh] = ssq;
    __syncthreads();
    const float tot = ((LAS float*)(lds + M_SOFF))[tq * 2] + ((LAS float*)(lds + M_SOFF))[tq * 2 + 1];
    const float rn = 1.0f / sqrtf(tot * (1.0f / 128.0f) + 1e-6f);
    const size_t tok = (size_t)b * SEQ + t0 + tq;
    const float* gn = P.in[7] + h * 128; bf16* mix = (bf16*)(ws + WS_BUFA) + tok * DM + 512 + h * 128;
#pragma unroll
    for (int et = 0; et < 4; ++et) { const int e = eh * 64 + et * 16 + 4 * g;
        const u32x2 mo = *(const u32x2*)(proj + tok * NPROJ + C_MO + h * 128 + e); const f32x4 gv = *(const f32x4*)(gn + e);
        const float m0 = bflo(mo.x), m1 = bfhi(mo.x), m2 = bflo(mo.y), m3 = bfhi(mo.y);
        const float y0 = hv[et][0] * rn * gv[0] / (1.0f + __expf(-m0)), y1 = hv[et][1] * rn * gv[1] / (1.0f + __expf(-m1));
        const float y2 = hv[et][2] * rn * gv[2] / (1.0f + __expf(-m2)), y3 = hv[et][3] * rn * gv[3] / (1.0f + __expf(-m3));
        u32x2 w; w.x = pk2(y0, y1); w.y = pk2(y2, y3); *(u32x2*)(mix + e) = w; }
    __syncthreads();
}

__device__ __forceinline__ void attn_combine(const Params& P) {
    unsigned char* ws = P.ws; const bf16* OP = (const bf16*)(ws + WS_OP); const float* LSE = (const float*)(ws + WS_LSE); bf16* mix = (bf16*)(ws + WS_BUFA);
    const int G = gridDim.x;
    for (int idx = blockIdx.x * 512 + threadIdx.x; idx < MT * 64; idx += G * 512) {
        const int tok = idx >> 6, cc = idx & 63, h = cc >> 3;
        const float l0 = LSE[(size_t)tok * 8 + h], l1 = LSE[(size_t)MT * 8 + (size_t)tok * 8 + h], l2 = LSE[(size_t)2 * MT * 8 + (size_t)tok * 8 + h];
        const float mx = fmaxf(l0, fmaxf(l1, l2)); float w0 = __expf(l0 - mx), w1 = __expf(l1 - mx), w2 = __expf(l2 - mx); const float iw = 1.0f / (w0 + w1 + w2); w0 *= iw; w1 *= iw; w2 *= iw;
        const u32x4 a = *(const u32x4*)(OP + (size_t)tok * 512 + cc * 8), bq = *(const u32x4*)(OP + (size_t)MT * 512 + (size_t)tok * 512 + cc * 8), cq = *(const u32x4*)(OP + (size_t)2 * MT * 512 + (size_t)tok * 512 + cc * 8);
        u32x4 o;
        o.x = pk2(w0 * bflo(a.x) + w1 * bflo(bq.x) + w2 * bflo(cq.x), w0 * bfhi(a.x) + w1 * bfhi(bq.x) + w2 * bfhi(cq.x));
        o.y = pk2(w0 * bflo(a.y) + w1 * bflo(bq.y) + w2 * bflo(cq.y), w0 * bfhi(a.y) + w1 * bfhi(bq.y) + w2 * bfhi(cq.y));
        o.z = pk2(w0 * bflo(a.z) + w1 * bflo(bq.z) + w2 * bflo(cq.z), w0 * bfhi(a.z) + w1 * bfhi(bq.z) + w2 * bfhi(cq.z));
        o.w = pk2(w0 * bflo(a.w) + w1 * bflo(bq.w) + w2 * bflo(cq.w), w0 * bfhi(a.w) + w1 * bfhi(bq.w) + w2 * bfhi(cq.w));
        *(u32x4*)(mix + (size_t)tok * DM + cc * 8) = o;
    }
}

__device__ __forceinline__ void final_norm(const Params& P) {
    const int lane = threadIdx.x & 63, wave = threadIdx.x >> 6, G = gridDim.x; const float* SSQ = (const float*)(P.ws + WS_SSQ3); const float* gf = P.in[15];
    f32x4 gv[4];
#pragma unroll
    for (int j = 0; j < 4; ++j) gv[j] = ((const f32x4*)gf)[lane + 64 * j];
    for (int row = blockIdx.x * 8 + wave; row < MT; row += G * 8) {
        const float rs = pg8::row_rs(SSQ, row); f32x4* o = (f32x4*)(P.out + (size_t)row * DM);
#pragma unroll
        for (int j = 0; j < 4; ++j) { const f32x4 v = o[lane + 64 * j]; o[lane + 64 * j] = v * rs * gv[j]; }
    }
}

__global__ void __launch_bounds__(512, 2) hymba_fwd(Params P) {
    extern __shared__ __attribute__((aligned(16))) unsigned char lds_raw[];
    LAS unsigned char* lds = (LAS unsigned char*)lds_raw;
    unsigned char* ws = P.ws; const int G = gridDim.x, bx = blockIdx.x;
    const int lo = P.ph_lo, hi = P.ph_hi;
#define IN(k) (lo <= (k) && (k) < hi)
#define SEAM(k) do { if (IN(k) && IN((k) + 1)) { cg::this_grid().sync(); } } while (0)
    if (IN(0)) { p0_prologue(P, lds); }
    SEAM(0);
    if (IN(1)) {
        if (bx < 32) gate_scan(P, bx, lds);
        pg8::Gemm gm{(const pg8::bf16_t*)(ws + WS_BUFA), (const pg8::bf16_t*)(ws + WS_WIN), MT, NPROJ, DM}; pg8::StaticOrder S; S.init(MT, NPROJ, G, bx);
        pg8::EpiStoreBf16 E{(pg8::bf16_t*)(ws + WS_PROJ), NPROJ};
        pg8::gemm_phase<pg8::EpiStoreBf16, pg8::StaticOrder>(lds, gm, S, E, nullptr);
    }
    SEAM(1);
    if (IN(2)) {
        for (int it = bx; it < 2048 + 6144; it += G) { if (it < 2048) mlstm_local_item(P, it, lds); else attn_item(P, it - 2048, lds); }
    }
    SEAM(2);
    if (IN(3)) { mlstm_scan(P); }
    SEAM(3);
    if (IN(4)) {
        for (int it = bx; it < 2048; it += G) mlstm_out_item(P, it, lds);
        attn_combine(P);
    }
    SEAM(4);
    if (IN(5)) {
        pg8::Gemm gm{(const pg8::bf16_t*)(ws + WS_BUFA), (const pg8::bf16_t*)(ws + WS_WOUT), MT, DM, DM}; pg8::StaticOrder S; S.init(MT, DM, G, bx);
        pg8::EpiRes E{P.in[0], P.out, (pg8::bf16_t*)(ws + WS_BUFB), (float*)(ws + WS_SSQ1)};
        pg8::gemm_phase<pg8::EpiRes, pg8::StaticOrder>(lds, gm, S, E, nullptr);
    }
    SEAM(5);
    if (IN(6)) {
        pg8::Gemm gm{(const pg8::bf16_t*)(ws + WS_BUFB), (const pg8::bf16_t*)(ws + WS_WUP), MT, FF, DM}; pg8::StaticOrder S; S.init(MT, FF, G, bx);
        pg8::EpiUp E{(pg8::bf16_t*)(ws + WS_ACT), (const float*)(ws + WS_SSQ1)};
        pg8::gemm_phase<pg8::EpiUp, pg8::StaticOrder>(lds, gm, S, E, nullptr);
    }
    SEAM(6);
    if (IN(7)) {
        pg8::Gemm gm{(const pg8::bf16_t*)(ws + WS_ACT), (const pg8::bf16_t*)(ws + WS_WDN), MT, DM, FF}; pg8::StaticOrder S; S.init(MT, DM, G, bx);
        pg8::EpiRes E{P.out, P.out, (pg8::bf16_t*)(ws + WS_BUFA), (float*)(ws + WS_SSQ2)};
        pg8::gemm_phase<pg8::EpiRes, pg8::StaticOrder>(lds, gm, S, E, nullptr);
    }
    SEAM(7);
    if (IN(8)) {
        { pg8::Gemm gm{(const pg8::bf16_t*)(ws + WS_PB), (const pg8::bf16_t*)(ws + WS_WPLE), MT, DM, PLE}; pg8::StaticOrder S; S.init(MT, DM, G, bx);
          pg8::EpiStoreBf16 E{(pg8::bf16_t*)(ws + WS_BUFB), DM};
          pg8::gemm_phase<pg8::EpiStoreBf16, pg8::StaticOrder>(lds, gm, S, E, nullptr); }
        __syncthreads();
        { pg8::Gemm gm{(const pg8::bf16_t*)(ws + WS_BUFA), (const pg8::bf16_t*)(ws + WS_WPG), MT, DM, DM}; pg8::StaticOrder S; S.init(MT, DM, G, bx);
          pg8::EpiPle E{P.out, (const pg8::bf16_t*)(ws + WS_BUFB), (const float*)(ws + WS_SSQ2), (float*)(ws + WS_SSQ3)};
          pg8::gemm_phase<pg8::EpiPle, pg8::StaticOrder>(lds, gm, S, E, nullptr); }
    }
    SEAM(8);
    if (IN(9)) { final_norm(P); }
#undef IN
#undef SEAM
}

extern "C" void kernel_launch(void* const* d_in, const int* in_sizes, int n_in, void* d_out, int out_size, void* d_ws, size_t ws_size, hipStream_t stream) {
    static int grid = 0;
    if (grid == 0) {
        if (n_in != 16 || out_size != MT * DM || ws_size < WS_END) { fprintf(stderr, "kernel_launch: unexpected shapes (n_in %d out %d ws %zu)\n", n_in, out_size, ws_size); grid = -1; return; }
        int dev = 0, cus = 0, per_cu = 0;
        (void)hipGetDevice(&dev); (void)hipDeviceGetAttribute(&cus, hipDeviceAttributeMultiprocessorCount, dev);
        if (hipFuncSetAttribute((const void*)hymba_fwd, hipFuncAttributeMaxDynamicSharedMemorySize, LDS_BYTES) != hipSuccess) { fprintf(stderr, "kernel_launch: hipFuncSetAttribute failed\n"); grid = -1; return; }
        if (hipOccupancyMaxActiveBlocksPerMultiprocessor(&per_cu, (const void*)hymba_fwd, 512, LDS_BYTES) != hipSuccess || per_cu < 1) { fprintf(stderr, "kernel_launch: occupancy query gave %d\n", per_cu); per_cu = 1; }
        (void)hipGetLastError();
        grid = cus;
        fprintf(stderr, "kernel_launch: grid %d (occupancy %d per CU)\n", grid, per_cu);
    }
    if (grid < 0) return;
    Params p{};
    for (int i = 0; i < 16; ++i) p.in[i] = (const float*)d_in[i];
    p.out = (float*)d_out; p.ws = (unsigned char*)d_ws;
#if MK_LAUNCHES == 1
    p.ph_lo = 0; p.ph_hi = 10;
    void* args[] = {&p};
    hipError_t e = hipLaunchCooperativeKernel((const void*)hymba_fwd, dim3(grid), dim3(512), args, LDS_BYTES, stream);
    if (e != hipSuccess) fprintf(stderr, "kernel_launch: cooperative launch failed: %s\n", hipGetErrorString(e));
#else
    for (int ph = 0; ph < 10; ++ph) { p.ph_lo = ph; p.ph_hi = ph + 1; hipLaunchKernelGGL(hymba_fwd, dim3(grid), dim3(512), LDS_BYTES, stream, p); }
#endif
}
```

```cpp
#include <hip/hip_runtime.h>
#include <hip/hip_cooperative_groups.h>
#include <cstdio>
#include <cstdint>
namespace cg = cooperative_groups;
#ifndef REP_PHASE
#define REP_PHASE -1
#endif
#ifndef MK_LAUNCHES
#define MK_LAUNCHES 1
#endif
namespace pg8 {
#define PG8_LAS __attribute__((address_space(3)))
typedef unsigned short bf16_t;
typedef short bf16x8 __attribute__((ext_vector_type(8)));
typedef float f32x4 __attribute__((ext_vector_type(4)));
typedef unsigned u32x4 __attribute__((ext_vector_type(4)));
constexpr int BM = 256, BK = 64, HALF = 128, HTB = HALF * BK * 2  , STAGE_BYTES = 8 * HTB, NXCD = 8, WGM = 8;

__host__ __device__ __forceinline__ int lds_byte(int r, int c) { const int st = (r >> 4) * 2 + (c >> 5), rr = r & 15, cc = c & 31, ob = rr * 64 + cc * 2; return st * 1024 + (ob ^ (((ob >> 9) & 1) << 5)); }
__host__ __device__ __forceinline__ void stage_rc(int b, int& R, int& C) { const int st = b / 1024, sb = b % 1024, swz = sb ^ (((sb >> 9) & 1) << 5); R = (st >> 1) * 16 + swz / 64; C = (st & 1) * 32 + (swz % 64) / 2; }
__host__ __device__ __forceinline__ int perm32(int rho) { const int n = rho >> 4, i = rho & 15; return 8 * (i >> 2) + 4 * n + (i & 3); }

struct Unit { int pm, pn; };
struct Gemm { const bf16_t* A; const bf16_t* Bt; int M, N, K; };

struct StaticOrder {
    int nM, nN, nwg, G, c;
    __host__ __device__ void init(int M, int N, int G_, int c_) { nM = M / BM; nN = N / BM; nwg = nM * nN; G = G_; c = c_; }
    __host__ __device__ bool next(int i, Unit& u) const {
        const long L = (long)i * G + c; if (L >= nwg) return false;
        int wgid = (int)L; { const int q = nwg / NXCD, r = nwg % NXCD, xcd = wgid % NXCD, off = wgid / NXCD; wgid = (xcd < r ? xcd * (q + 1) : r * (q + 1) + (xcd - r) * q) + off; }
        const int nig = WGM * nN, gid = wgid / nig, fm = gid * WGM, gsz = (nM - fm) < WGM ? (nM - fm) : WGM;
        u.pm = fm + ((wgid % nig) % gsz); u.pn = (wgid % nig) / gsz; return true;
    }
    __device__ __forceinline__ void a_ready(const Unit&) const {}
    __device__ __forceinline__ void done(const Unit&) const {}
};
typedef __bf16 bf16x2_t __attribute__((ext_vector_type(2)));
typedef float f32x2_t __attribute__((ext_vector_type(2)));
__device__ __forceinline__ unsigned cvt_pk_bf16(float lo, float hi) { const f32x2_t v = {lo, hi}; return __builtin_bit_cast(unsigned, __builtin_convertvector(v, bf16x2_t)); }
constexpr float RMS_EPS_F = 1e-6f;
__device__ __forceinline__ float bf_lo(unsigned w) { return __builtin_bit_cast(float, w << 16); }
__device__ __forceinline__ float bf_hi(unsigned w) { return __builtin_bit_cast(float, w & 0xffff0000u); }
__device__ __forceinline__ float row_rs(const float* ssq, int row) {
    const f32x4* sp = (const f32x4*)(ssq + (size_t)row * 16);
    const f32x4 t = (sp[0] + sp[1]) + (sp[2] + sp[3]);
    return __builtin_amdgcn_rsqf(((t[0] + t[1]) + (t[2] + t[3])) * (1.0f / 1024.0f) + RMS_EPS_F);
}
__device__ __forceinline__ float rs_from_quarter(const f32x4 t) {
    float s = (t[0] + t[1]) + (t[2] + t[3]); s += __shfl_xor(s, 16); s += __shfl_xor(s, 32);
    return __builtin_amdgcn_rsqf(s * (1.0f / 1024.0f) + RMS_EPS_F);
}
struct EpiStoreBf16 {
    static constexpr bool PERM = true, AFTER_DRAIN = false;
    bf16_t* O; int ldc;
    __device__ __forceinline__ void operator()(const f32x4 (&acc)[2][2][4][2], const Unit& u, int wr, int wc, int fr, int fq) const {
        const int row0 = u.pm * BM + wr * 64 + fr, col0 = u.pn * BM + wc * 32 + 8 * fq;
#pragma unroll
        for (int ai = 0; ai < 2; ++ai)
#pragma unroll
            for (int m = 0; m < 4; ++m) { bf16_t* rowp = O + (size_t)(row0 + ai * HALF + m * 16) * ldc + col0;
#pragma unroll
                for (int bj = 0; bj < 2; ++bj) { const f32x4 v0 = acc[ai][bj][m][0], v1 = acc[ai][bj][m][1];
                    u32x4 w; w.x = cvt_pk_bf16(v0[0], v0[1]); w.y = cvt_pk_bf16(v0[2], v0[3]); w.z = cvt_pk_bf16(v1[0], v1[1]); w.w = cvt_pk_bf16(v1[2], v1[3]);
                    *(u32x4*)(rowp + bj * HALF) = w; } }
    }
};
struct EpiProj {
    static constexpr bool PERM = true, AFTER_DRAIN = false;
    bf16_t* QKV; bf16_t* MP; const float* rc; const float* rsn;
    __device__ __forceinline__ void operator()(const f32x4 (&acc)[2][2][4][2], const Unit& u, int wr, int wc, int fr, int fq) const {
        const int row0 = u.pm * BM + wr * 64 + fr, col0 = u.pn * BM + wc * 32 + 8 * fq;
        const bool rope = (u.pn < 4) && ((wc & 1) == 0);
        size_t cofs[2];
#pragma unroll
        for (int bj = 0; bj < 2; ++bj) { const int col = col0 + bj * HALF;
            if (u.pn < 6) { const int sect = col >> 9, h = (col >> 6) & 7, d = col & 63; cofs[bj] = ((size_t)(sect * 64 + h) * 4096) * 64 + d; }
            else { const int c2 = col - 1536, sect = c2 >> 9, h = (c2 >> 7) & 3, d = c2 & 127; cofs[bj] = ((size_t)(sect * 32 + h) * 4096) * 128 + d; } }
        bf16_t* base = (u.pn < 6) ? QKV : MP; const int rsh = (u.pn < 6) ? 6 : 7; const size_t bstride = (u.pn < 6) ? (size_t)8 * 4096 * 64 : (size_t)4 * 4096 * 128;
#pragma unroll
        for (int ai = 0; ai < 2; ++ai)
#pragma unroll
            for (int m = 0; m < 4; ++m) { const int row = row0 + ai * HALF + m * 16; const int b = row >> 12, t = row & 4095; bf16_t* rowp = base + (size_t)b * bstride + ((size_t)t << rsh);
                f32x4 c0 = (f32x4){1.f, 1.f, 1.f, 1.f}, c1 = c0, s0 = (f32x4){0.f, 0.f, 0.f, 0.f}, s1 = s0;
                if (rope) { c0 = *(const f32x4*)(rc + t * 8); c1 = *(const f32x4*)(rc + t * 8 + 4); s0 = *(const f32x4*)(rsn + t * 8); s1 = *(const f32x4*)(rsn + t * 8 + 4);
                    if (fq == 0) { s0 = -s0; s1 = -s1; } if (fq >= 2) { c0 = (f32x4){1.f, 1.f, 1.f, 1.f}; c1 = c0; s0 = (f32x4){0.f, 0.f, 0.f, 0.f}; s1 = s0; } }
#pragma unroll
                for (int bj = 0; bj < 2; ++bj) { f32x4 v0 = acc[ai][bj][m][0], v1 = acc[ai][bj][m][1];
                    if (rope) { f32x4 p0, p1;
#pragma unroll
                        for (int j = 0; j < 4; ++j) { p0[j] = __shfl_xor(v0[j], 16); p1[j] = __shfl_xor(v1[j], 16); }
                        v0 = v0 * c0 + p0 * s0; v1 = v1 * c1 + p1 * s1; }
                    u32x4 w; w.x = cvt_pk_bf16(v0[0], v0[1]); w.y = cvt_pk_bf16(v0[2], v0[3]); w.z = cvt_pk_bf16(v1[0], v1[1]); w.w = cvt_pk_bf16(v1[2], v1[3]);
                    *(u32x4*)(rowp + cofs[bj]) = w; } }
    }
};
template <bool BASE_BF16> struct EpiRes {
    static constexpr bool PERM = true, AFTER_DRAIN = false;
    const void* base; bf16_t* HB; float* SSQ;
    __device__ __forceinline__ void operator()(const f32x4 (&acc)[2][2][4][2], const Unit& u, int wr, int wc, int fr, int fq) const {
        const int row0 = u.pm * BM + wr * 64 + fr, col0 = u.pn * BM + wc * 32 + 8 * fq;
        constexpr int NB = BASE_BF16 ? 1 : 2, AIB = BASE_BF16 ? 2 : 1;
#pragma unroll
        for (int bt = 0; bt < NB; ++bt) {
            f32x4 bb[AIB][4][2][BASE_BF16 ? 1 : 2];
#pragma unroll
            for (int a = 0; a < AIB; ++a)
#pragma unroll
                for (int m = 0; m < 4; ++m)
#pragma unroll
                    for (int bj = 0; bj < 2; ++bj) { const int ai = bt * AIB + a; const size_t o = (size_t)(row0 + ai * HALF + m * 16) * 1024 + col0 + bj * HALF;
                        if (BASE_BF16) { const u32x4 w = *(const u32x4*)((const bf16_t*)base + o); bb[a][m][bj][0] = __builtin_bit_cast(f32x4, w); }
                        else { bb[a][m][bj][0] = *(const f32x4*)((const float*)base + o); bb[a][m][bj][BASE_BF16 ? 0 : 1] = *(const f32x4*)((const float*)base + o + 4); } }
#pragma unroll
            for (int a = 0; a < AIB; ++a)
#pragma unroll
                for (int m = 0; m < 4; ++m) { const int ai = bt * AIB + a; const int row = row0 + ai * HALF + m * 16; const size_t ro = (size_t)row * 1024 + col0; float ss = 0.f;
#pragma unroll
                    for (int bj = 0; bj < 2; ++bj) {
                        f32x4 b0, b1;
                        if (BASE_BF16) { const u32x4 w = __builtin_bit_cast(u32x4, bb[a][m][bj][0]); b0 = (f32x4){bf_lo(w.x), bf_hi(w.x), bf_lo(w.y), bf_hi(w.y)}; b1 = (f32x4){bf_lo(w.z), bf_hi(w.z), bf_lo(w.w), bf_hi(w.w)}; }
                        else { b0 = bb[a][m][bj][0]; b1 = bb[a][m][bj][BASE_BF16 ? 0 : 1]; }
                        const f32x4 v0 = acc[ai][bj][m][0] + b0, v1 = acc[ai][bj][m][1] + b1;
                        u32x4 w; w.x = cvt_pk_bf16(v0[0], v0[1]); w.y = cvt_pk_bf16(v0[2], v0[3]); w.z = cvt_pk_bf16(v1[0], v1[1]); w.w = cvt_pk_bf16(v1[2], v1[3]);
                        *(u32x4*)(HB + ro + bj * HALF) = w;
                        ss += (v0[0] * v0[0] + v0[1] * v0[1]) + (v0[2] * v0[2] + v0[3] * v0[3]) + (v1[0] * v1[0] + v1[1] * v1[1]) + (v1[2] * v1[2] + v1[3] * v1[3]); }
                    ss += __shfl_xor(ss, 16); ss += __shfl_xor(ss, 32);
                    if (fq == 0) SSQ[(size_t)row * 16 + u.pn * 4 + wc] = ss; }
        }
    }
};
struct EpiUp {
    static constexpr bool PERM = true, AFTER_DRAIN = false;
    bf16_t* O; const float* SSQ;
    __device__ __forceinline__ void operator()(const f32x4 (&acc)[2][2][4][2], const Unit& u, int wr, int wc, int fr, int fq) const {
        const int row0 = u.pm * BM + wr * 64 + fr, col0 = u.pn * BM + wc * 32 + 8 * fq;
#pragma unroll
        for (int ai = 0; ai < 2; ++ai) {
            f32x4 qv[4];
#pragma unroll
            for (int m = 0; m < 4; ++m) qv[m] = *(const f32x4*)(SSQ + (size_t)(row0 + ai * HALF + m * 16) * 16 + 4 * fq);
#pragma unroll
            for (int m = 0; m < 4; ++m) { const int row = row0 + ai * HALF + m * 16; const float rs = rs_from_quarter(qv[m]); bf16_t* rowp = O + (size_t)row * 4096 + col0;
#pragma unroll
                for (int bj = 0; bj < 2; ++bj) { f32x4 v0 = acc[ai][bj][m][0] * rs, v1 = acc[ai][bj][m][1] * rs;
#pragma unroll
                    for (int j = 0; j < 4; ++j) { const float a = fmaxf(v0[j], 0.f), b = fmaxf(v1[j], 0.f); v0[j] = a * a; v1[j] = b * b; }
                    u32x4 w; w.x = cvt_pk_bf16(v0[0], v0[1]); w.y = cvt_pk_bf16(v0[2], v0[3]); w.z = cvt_pk_bf16(v1[0], v1[1]); w.w = cvt_pk_bf16(v1[2], v1[3]);
                    *(u32x4*)(rowp + bj * HALF) = w; } } }
    }
};
struct EpiPle {
    static constexpr bool PERM = true, AFTER_DRAIN = false;
    const bf16_t* H2; bf16_t* EH; const float* SSQ; float* SSQO;
    __device__ __forceinline__ void operator()(const f32x4 (&acc)[2][2][4][2], const Unit& u, int wr, int wc, int fr, int fq) const {
        const int row0 = u.pm * BM + wr * 64 + fr, col0 = u.pn * BM + wc * 32 + 8 * fq;
#pragma unroll
        for (int ai = 0; ai < 2; ++ai)
#pragma unroll
            for (int mp = 0; mp < 2; ++mp) {
                u32x4 hw[2][2], ew[2][2]; f32x4 qv[2];
#pragma unroll
                for (int mi = 0; mi < 2; ++mi) { const int row = row0 + ai * HALF + (2 * mp + mi) * 16; qv[mi] = *(const f32x4*)(SSQ + (size_t)row * 16 + 4 * fq);
#pragma unroll
                    for (int bj = 0; bj < 2; ++bj) { const size_t o = (size_t)row * 1024 + col0 + bj * HALF; hw[mi][bj] = *(const u32x4*)(H2 + o); ew[mi][bj] = *(const u32x4*)(EH + o); } }
#pragma unroll
                for (int mi = 0; mi < 2; ++mi) { const int m = 2 * mp + mi; const int row = row0 + ai * HALF + m * 16; const float rs = rs_from_quarter(qv[mi]); const size_t ro = (size_t)row * 1024 + col0; float ss = 0.f;
#pragma unroll
                    for (int bj = 0; bj < 2; ++bj) { const u32x4 h = hw[mi][bj], e = ew[mi][bj];
                        const f32x4 b0 = (f32x4){bf_lo(h.x), bf_hi(h.x), bf_lo(h.y), bf_hi(h.y)}, b1 = (f32x4){bf_lo(h.z), bf_hi(h.z), bf_lo(h.w), bf_hi(h.w)};
                        const f32x4 e0 = (f32x4){bf_lo(e.x), bf_hi(e.x), bf_lo(e.y), bf_hi(e.y)}, e1 = (f32x4){bf_lo(e.z), bf_hi(e.z), bf_lo(e.w), bf_hi(e.w)};
                        f32x4 v0, v1;
#pragma unroll
                        for (int j = 0; j < 4; ++j) {
                            const float g0 = __builtin_amdgcn_rcpf(1.0f + __expf(-acc[ai][bj][m][0][j] * rs)), g1 = __builtin_amdgcn_rcpf(1.0f + __expf(-acc[ai][bj][m][1][j] * rs));
                            v0[j] = b0[j] + g0 * e0[j]; v1[j] = b1[j] + g1 * e1[j]; }
                        u32x4 w; w.x = cvt_pk_bf16(v0[0], v0[1]); w.y = cvt_pk_bf16(v0[2], v0[3]); w.z = cvt_pk_bf16(v1[0], v1[1]); w.w = cvt_pk_bf16(v1[2], v1[3]);
                        *(u32x4*)(EH + ro + bj * HALF) = w;
                        ss += (v0[0] * v0[0] + v0[1] * v0[1]) + (v0[2] * v0[2] + v0[3] * v0[3]) + (v1[0] * v1[0] + v1[1] * v1[1]) + (v1[2] * v1[2] + v1[3] * v1[3]); }
                    ss += __shfl_xor(ss, 16); ss += __shfl_xor(ss, 32);
                    if (fq == 0) SSQO[(size_t)row * 16 + u.pn * 4 + wc] = ss; }
            }
    }
};
template <class Epi, class Sched, bool STAMP = false>
__device__ __forceinline__ void gemm_phase(PG8_LAS unsigned char* lds, const Gemm g, const Sched& S, const Epi& E, unsigned long long* stamps) {
    const int tid = threadIdx.x, wid = __builtin_amdgcn_readfirstlane(tid >> 6), lane = tid & 63, wr = wid >> 2, wc = wid & 3, fr = lane & 15, fq = lane >> 4;
    const int K = g.K, nt = K / BK;
    int ts_lo = 0, ts_hi = 0, nts = 0; const unsigned long long rt_entry = STAMP ? (unsigned long long)wall_clock64() : 0ull;
#define PG8_STAMP() do { if (STAMP && wid == 0 && nts < 64) { const unsigned long long _c = (unsigned long long)clock64(); \
        ts_lo = (lane == nts) ? (int)(unsigned)_c : ts_lo; ts_hi = (lane == nts) ? (int)(unsigned)(_c >> 32) : ts_hi; ++nts; } } while (0)
    PG8_STAMP();
    unsigned voffA[2], voffB[2];
#pragma unroll
    for (int i = 0; i < 2; ++i) { int R, C; stage_rc(tid * 16 + i * 8192, R, C); const int Rb = Epi::PERM ? ((R & ~31) + perm32(R & 31)) : R;
        voffA[i] = (unsigned)(R * K + C) * 2u; voffB[i] = (unsigned)(Rb * K + C) * 2u; }
    const size_t kstep = (size_t)(BK * 2);
    const size_t hstep = (size_t)HALF * K * 2;
    const size_t tstep = 2 * hstep;
    const unsigned ldsw = (unsigned)wid * 1024u;
    const int aoff = lds_byte(wr * 64 + fr, fq * 8), boff = lds_byte(wc * 32 + fr, fq * 8);
#define PG8_SA(b, h) (((b) * 2 + (h)) * HTB)
#define PG8_SB(b, h) ((4 + (b) * 2 + (h)) * HTB)
#define PG8_STAGE(bufoff, gbase, voff) do { _Pragma("unroll") for (int _i = 0; _i < 2; ++_i) \
        __builtin_amdgcn_global_load_lds((const unsigned*)((const char*)(gbase) + (voff)[_i]), (PG8_LAS unsigned*)(lds + (bufoff) + ldsw + _i * 8192), 16, 0, 0); } while (0)
#define PG8_LDA(dst, b, h) do { _Pragma("unroll") for (int m = 0; m < 4; ++m) _Pragma("unroll") for (int k = 0; k < 2; ++k) dst[m][k] = *(const PG8_LAS bf16x8*)(lds + PG8_SA(b, h) + aoff + m * 2048 + k * 1024); } while (0)
#define PG8_LDB(dst, b, h) do { _Pragma("unroll") for (int n = 0; n < 2; ++n) _Pragma("unroll") for (int k = 0; k < 2; ++k) dst[n][k] = *(const PG8_LAS bf16x8*)(lds + PG8_SB(b, h) + boff + n * 2048 + k * 1024); } while (0)
#define PG8_MMA(ai, bj, At, Bt) do { __builtin_amdgcn_s_setprio(1); _Pragma("unroll") for (int m = 0; m < 4; ++m) _Pragma("unroll") for (int n = 0; n < 2; ++n) _Pragma("unroll") for (int k = 0; k < 2; ++k) \
        acc[ai][bj][m][n] = __builtin_amdgcn_mfma_f32_16x16x32_bf16(Bt[n][k], At[m][k], acc[ai][bj][m][n], 0, 0, 0); __builtin_amdgcn_s_setprio(0); } while (0)
#define PG8_WAIT_V(n) asm volatile("s_waitcnt vmcnt(" #n ")" ::: "memory")
#define PG8_WAIT_L(n) asm volatile("s_waitcnt lgkmcnt(" #n ")" ::: "memory")
#define PG8_BAR __builtin_amdgcn_s_barrier()
#define PG8_SCHED __builtin_amdgcn_sched_barrier(0)
    Unit cur, nxt; int ui = 0;
    if (!S.next(0, cur)) return;
    f32x4 acc[2][2][4][2];
#pragma unroll
    for (int a = 0; a < 2; ++a)
#pragma unroll
        for (int b = 0; b < 2; ++b)
#pragma unroll
            for (int m = 0; m < 4; ++m)
#pragma unroll
                for (int n = 0; n < 2; ++n) acc[a][b][m][n] = (f32x4){0.f, 0.f, 0.f, 0.f};
    bf16x8 At[4][2], B0[2][2], B1[2][2];
    const char* cA = (const char*)g.A + (size_t)cur.pm * tstep; const char* cB = (const char*)g.Bt + (size_t)cur.pn * tstep;
    S.a_ready(cur);
    PG8_STAGE(PG8_SB(0, 0), cB, voffB); PG8_STAGE(PG8_SA(0, 0), cA, voffA); PG8_STAGE(PG8_SB(0, 1), cB + hstep, voffB); PG8_STAGE(PG8_SA(0, 1), cA + hstep, voffA);
    if (wr == 1) PG8_BAR;
    PG8_WAIT_V(4); PG8_BAR;
    PG8_STAGE(PG8_SB(1, 0), cB + kstep, voffB); PG8_STAGE(PG8_SA(1, 0), cA + kstep, voffA); PG8_STAGE(PG8_SB(1, 1), cB + hstep + kstep, voffB);
    PG8_WAIT_V(6); PG8_BAR;
    PG8_STAMP();
    for (;;) {
        const bool has_next = S.next(ui + 1, nxt);
        const char* nA = has_next ? (const char*)g.A + (size_t)nxt.pm * tstep : cA; const char* nB = has_next ? (const char*)g.Bt + (size_t)nxt.pn * tstep : cB;
        for (int t = 0; t < nt; t += 2) {
            const bool last = (t == nt - 2);
            const char* a1 = cA + (size_t)(t + 1) * kstep;
            const char* a2 = last ? nA : cA + (size_t)(t + 2) * kstep; const char* b2 = last ? nB : cB + (size_t)(t + 2) * kstep;
            const char* a3 = a2 + kstep; const char* b3 = b2 + kstep;
            if (last && has_next) S.a_ready(nxt);
            PG8_LDB(B0, 0, 0); PG8_SCHED; PG8_LDA(At, 0, 0); PG8_STAGE(PG8_SA(1, 1), a1 + hstep, voffA);
            PG8_WAIT_L(8); PG8_BAR; PG8_WAIT_L(0); PG8_MMA(0, 0, At, B0); PG8_BAR; PG8_SCHED;
            PG8_LDB(B1, 0, 1); PG8_STAGE(PG8_SB(0, 0), b2, voffB);
            PG8_BAR; PG8_WAIT_L(0); PG8_MMA(0, 1, At, B1); PG8_BAR;
            PG8_LDA(At, 0, 1); PG8_STAGE(PG8_SA(0, 0), a2, voffA);
            PG8_BAR; PG8_WAIT_L(0); PG8_MMA(1, 0, At, B0); PG8_BAR; PG8_SCHED;
            PG8_STAGE(PG8_SB(0, 1), b2 + hstep, voffB);
            PG8_WAIT_V(6); PG8_BAR; PG8_MMA(1, 1, At, B1); PG8_BAR;
            PG8_LDB(B0, 1, 0); PG8_SCHED; PG8_LDA(At, 1, 0); PG8_STAGE(PG8_SA(0, 1), a2 + hstep, voffA);
            PG8_WAIT_L(8); PG8_BAR; PG8_WAIT_L(0); PG8_MMA(0, 0, At, B0); PG8_BAR; PG8_SCHED;
            PG8_LDB(B1, 1, 1); PG8_STAGE(PG8_SB(1, 0), b3, voffB);
            PG8_BAR; PG8_WAIT_L(0); PG8_MMA(0, 1, At, B1); PG8_BAR;
            PG8_LDA(At, 1, 1); PG8_STAGE(PG8_SA(1, 0), a3, voffA);
            PG8_BAR; PG8_WAIT_L(0); PG8_MMA(1, 0, At, B0); PG8_BAR; PG8_SCHED;
            PG8_STAGE(PG8_SB(1, 1), b3 + hstep, voffB);
            PG8_WAIT_V(6); PG8_BAR; PG8_MMA(1, 1, At, B1); PG8_BAR;
        }
        PG8_STAMP();
        if constexpr (!Epi::AFTER_DRAIN) { E(acc, cur, wr, wc, fr, fq); S.done(cur); }
        PG8_STAMP();
        if (!has_next) break;
#pragma unroll
        for (int a = 0; a < 2; ++a)
#pragma unroll
            for (int b = 0; b < 2; ++b)
#pragma unroll
                for (int m = 0; m < 4; ++m)
#pragma unroll
                    for (int n = 0; n < 2; ++n) acc[a][b][m][n] = (f32x4){0.f, 0.f, 0.f, 0.f};
        cur = nxt; cA = nA; cB = nB; ++ui;
    }
    PG8_WAIT_V(0);
    if (wr == 0) PG8_BAR;
    PG8_BAR;
    if constexpr (Epi::AFTER_DRAIN) { E.fused(acc, cur, wr, wc, fr, fq, lds, wid, lane); S.done(cur); }
    PG8_STAMP();
    if (STAMP && wid == 0) { stamps[lane] = lane < nts ? (((unsigned long long)(unsigned)ts_hi << 32) | (unsigned)ts_lo) : 0ull;
        if (lane == 62) stamps[62] = rt_entry; if (lane == 63) stamps[63] = (unsigned long long)wall_clock64(); }
#undef PG8_STAMP
#undef PG8_SA
#undef PG8_SB
#undef PG8_STAGE
#undef PG8_LDA
#undef PG8_LDB
#undef PG8_MMA
#undef PG8_WAIT_V
#undef PG8_WAIT_L
#undef PG8_BAR
#undef PG8_SCHED
}
template <class Epi, class Sched, bool ALIGN_EPI = false, bool SP2 = false>
__device__ __forceinline__ void gemm_phase_sp(PG8_LAS unsigned char* lds, const Gemm g, const Sched& S, const Epi& E) {
    const int tid = threadIdx.x, wid = __builtin_amdgcn_readfirstlane(tid >> 6), lane = tid & 63, wr = wid >> 2, wc = wid & 3, fr = lane & 15, fq = lane >> 4;
    const int K = g.K, nt = K / BK;
    unsigned voffA[2], voffB[2];
#pragma unroll
    for (int i = 0; i < 2; ++i) { int R, C; stage_rc(tid * 16 + i * 8192, R, C); const int Rb = Epi::PERM ? ((R & ~31) + perm32(R & 31)) : R;
        voffA[i] = (unsigned)(R * K + C) * 2u; voffB[i] = (unsigned)(Rb * K + C) * 2u; }
    const size_t kstep = (size_t)(BK * 2);
    const size_t hstep = (size_t)HALF * K * 2;
    const size_t tstep = 2 * hstep;
    const unsigned ldsw = (unsigned)wid * 1024u;
    const int aoff = lds_byte(wr * 64 + fr, fq * 8), boff = lds_byte(wc * 32 + fr, fq * 8);
#define PG8_SA(b, h) (((b) * 2 + (h)) * HTB)
#define PG8_SB(b, h) ((4 + (b) * 2 + (h)) * HTB)
#define PG8_STAGE(bufoff, gbase, voff) do { _Pragma("unroll") for (int _i = 0; _i < 2; ++_i) \
        __builtin_amdgcn_global_load_lds((const unsigned*)((const char*)(gbase) + (voff)[_i]), (PG8_LAS unsigned*)(lds + (bufoff) + ldsw + _i * 8192), 16, 0, 0); } while (0)
#define PG8_LDA(dst, b, h) do { _Pragma("unroll") for (int m = 0; m < 4; ++m) _Pragma("unroll") for (int k = 0; k < 2; ++k) dst[m][k] = *(const PG8_LAS bf16x8*)(lds + PG8_SA(b, h) + aoff + m * 2048 + k * 1024); } while (0)
#define PG8_LDB(dst, b, h) do { _Pragma("unroll") for (int n = 0; n < 2; ++n) _Pragma("unroll") for (int k = 0; k < 2; ++k) dst[n][k] = *(const PG8_LAS bf16x8*)(lds + PG8_SB(b, h) + boff + n * 2048 + k * 1024); } while (0)
#define PG8_MMA(ai, bj, At, Bt) do { __builtin_amdgcn_s_setprio(1); _Pragma("unroll") for (int m = 0; m < 4; ++m) _Pragma("unroll") for (int n = 0; n < 2; ++n) _Pragma("unroll") for (int k = 0; k < 2; ++k) \
        acc[ai][bj][m][n] = __builtin_amdgcn_mfma_f32_16x16x32_bf16(Bt[n][k], At[m][k], acc[ai][bj][m][n], 0, 0, 0); __builtin_amdgcn_s_setprio(0); } while (0)
#define PG8_WAIT_V(n) asm volatile("s_waitcnt vmcnt(" #n ")" ::: "memory")
#define PG8_WAIT_L(n) asm volatile("s_waitcnt lgkmcnt(" #n ")" ::: "memory")
#define PG8_BAR __builtin_amdgcn_s_barrier()
#define PG8_SCHED __builtin_amdgcn_sched_barrier(0)
    Unit cur, nxt; int ui = 0;
    if (!S.next(0, cur)) return;
    f32x4 acc[2][2][4][2];
#pragma unroll
    for (int a = 0; a < 2; ++a)
#pragma unroll
        for (int b = 0; b < 2; ++b)
#pragma unroll
            for (int m = 0; m < 4; ++m)
#pragma unroll
                for (int n = 0; n < 2; ++n) acc[a][b][m][n] = (f32x4){0.f, 0.f, 0.f, 0.f};
    bf16x8 At[4][2], B0[2][2], B1[2][2];
    const char* cA = (const char*)g.A + (size_t)cur.pm * tstep; const char* cB = (const char*)g.Bt + (size_t)cur.pn * tstep;
    S.a_ready(cur);
    if constexpr (SP2) {
        PG8_STAGE(PG8_SB(0, 0), cB, voffB); PG8_STAGE(PG8_SB(0, 1), cB + hstep, voffB); PG8_STAGE(PG8_SA(0, 0), cA, voffA); PG8_STAGE(PG8_SA(0, 1), cA + hstep, voffA);
        if (wr == 1) PG8_BAR;
        PG8_WAIT_V(2); PG8_BAR;
        PG8_STAGE(PG8_SB(1, 0), cB + kstep, voffB); PG8_STAGE(PG8_SA(1, 0), cA + kstep, voffA); PG8_STAGE(PG8_SB(1, 1), cB + hstep + kstep, voffB);
        PG8_WAIT_V(6); PG8_BAR;
    } else {
        PG8_STAGE(PG8_SB(0, 0), cB, voffB); PG8_STAGE(PG8_SA(0, 0), cA, voffA); PG8_STAGE(PG8_SB(0, 1), cB + hstep, voffB); PG8_STAGE(PG8_SA(0, 1), cA + hstep, voffA);
        if (wr == 1) PG8_BAR;
        PG8_WAIT_V(4); PG8_BAR;
        PG8_STAGE(PG8_SB(1, 0), cB + kstep, voffB); PG8_STAGE(PG8_SA(1, 0), cA + kstep, voffA); PG8_STAGE(PG8_SB(1, 1), cB + hstep + kstep, voffB);
        PG8_WAIT_V(6); PG8_BAR;
    }
    for (;;) {
        const bool has_next = S.next(ui + 1, nxt);
        const char* nA = has_next ? (const char*)g.A + (size_t)nxt.pm * tstep : cA; const char* nB = has_next ? (const char*)g.Bt + (size_t)nxt.pn * tstep : cB;
        for (int t = 0; t < nt; t += 2) {
            const bool last = (t == nt - 2);
            const char* a1 = cA + (size_t)(t + 1) * kstep;
            const char* a2 = last ? nA : cA + (size_t)(t + 2) * kstep; const char* b2 = last ? nB : cB + (size_t)(t + 2) * kstep;
            const char* a3 = a2 + kstep; const char* b3 = b2 + kstep;
            if (last && has_next) S.a_ready(nxt);
            if constexpr (SP2) {
            PG8_LDB(B0, 0, 0); PG8_LDB(B1, 0, 1); PG8_SCHED; PG8_LDA(At, 0, 0); PG8_STAGE(PG8_SA(1, 1), a1 + hstep, voffA);
            PG8_WAIT_V(8); PG8_WAIT_L(0); PG8_BAR; PG8_MMA(0, 0, At, B0); PG8_MMA(0, 1, At, B1); PG8_BAR; PG8_SCHED;
            PG8_LDA(At, 0, 1); PG8_STAGE(PG8_SB(0, 0), b2, voffB); PG8_STAGE(PG8_SB(0, 1), b2 + hstep, voffB); PG8_STAGE(PG8_SA(0, 0), a2, voffA);
            PG8_WAIT_V(8); PG8_WAIT_L(0); PG8_BAR; PG8_MMA(1, 0, At, B0); PG8_MMA(1, 1, At, B1); PG8_BAR; PG8_SCHED;
            PG8_LDB(B0, 1, 0); PG8_LDB(B1, 1, 1); PG8_SCHED; PG8_LDA(At, 1, 0); PG8_STAGE(PG8_SA(0, 1), a2 + hstep, voffA);
            PG8_WAIT_V(8); PG8_WAIT_L(0); PG8_BAR; PG8_MMA(0, 0, At, B0); PG8_MMA(0, 1, At, B1); PG8_BAR; PG8_SCHED;
            PG8_LDA(At, 1, 1); PG8_STAGE(PG8_SB(1, 0), b3, voffB); PG8_STAGE(PG8_SB(1, 1), b3 + hstep, voffB); PG8_STAGE(PG8_SA(1, 0), a3, voffA);
            PG8_WAIT_V(8); PG8_WAIT_L(0); PG8_BAR; PG8_MMA(1, 0, At, B0); PG8_MMA(1, 1, At, B1); PG8_BAR; PG8_SCHED;
            } else {
            PG8_LDB(B0, 0, 0); PG8_SCHED; PG8_LDA(At, 0, 0); PG8_STAGE(PG8_SA(1, 1), a1 + hstep, voffA);
            PG8_WAIT_L(8); PG8_BAR; PG8_WAIT_L(0); PG8_MMA(0, 0, At, B0); PG8_BAR; PG8_SCHED;
            PG8_LDB(B1, 0, 1); PG8_STAGE(PG8_SB(0, 0), b2, voffB);
            PG8_BAR; PG8_WAIT_L(0); PG8_MMA(0, 1, At, B1); PG8_BAR;
            PG8_LDA(At, 0, 1); PG8_STAGE(PG8_SA(0, 0), a2, voffA);
            PG8_BAR; PG8_WAIT_L(0); PG8_MMA(1, 0, At, B0); PG8_BAR; PG8_SCHED;
            PG8_STAGE(PG8_SB(0, 1), b2 + hstep, voffB);
            PG8_WAIT_V(6); PG8_BAR; PG8_MMA(1, 1, At, B1); PG8_BAR;
            PG8_LDB(B0, 1, 0); PG8_SCHED; PG8_LDA(At, 1, 0); PG8_STAGE(PG8_SA(0, 1), a2 + hstep, voffA);
            PG8_WAIT_L(8); PG8_BAR; PG8_WAIT_L(0); PG8_MMA(0, 0, At, B0); PG8_BAR; PG8_SCHED;
            PG8_LDB(B1, 1, 1); PG8_STAGE(PG8_SB(1, 0), b3, voffB);
            PG8_BAR; PG8_WAIT_L(0); PG8_MMA(0, 1, At, B1); PG8_BAR;
            PG8_LDA(At, 1, 1); PG8_STAGE(PG8_SA(1, 0), a3, voffA);
            PG8_BAR; PG8_WAIT_L(0); PG8_MMA(1, 0, At, B0); PG8_BAR; PG8_SCHED;
            PG8_STAGE(PG8_SB(1, 1), b3 + hstep, voffB);
            PG8_WAIT_V(6); PG8_BAR; PG8_MMA(1, 1, At, B1); PG8_BAR;
            }
        }
        if constexpr (ALIGN_EPI) { if (wr == 0) PG8_BAR; }
        if constexpr (!Epi::AFTER_DRAIN) { E(acc, cur, wr, wc, fr, fq); S.done(cur); }
        if (!has_next) break;
#pragma unroll
        for (int a = 0; a < 2; ++a)
#pragma unroll
            for (int b = 0; b < 2; ++b)
#pragma unroll
                for (int m = 0; m < 4; ++m)
#pragma unroll
                    for (int n = 0; n < 2; ++n) acc[a][b][m][n] = (f32x4){0.f, 0.f, 0.f, 0.f};
        cur = nxt; cA = nA; cB = nB; ++ui;
        if constexpr (ALIGN_EPI) { if (wr == 1) PG8_BAR; }
    }
    PG8_WAIT_V(0);
    if constexpr (!ALIGN_EPI) { if (wr == 0) PG8_BAR; }
    PG8_BAR;
    if constexpr (Epi::AFTER_DRAIN) { E.fused(acc, cur, wr, wc, fr, fq, lds, wid, lane); S.done(cur); }
#undef PG8_SA
#undef PG8_SB
#undef PG8_STAGE
#undef PG8_LDA
#undef PG8_LDB
#undef PG8_MMA
#undef PG8_WAIT_V
#undef PG8_WAIT_L
#undef PG8_BAR
#undef PG8_SCHED
}
}
#define LAS __attribute__((address_space(3)))
typedef unsigned short bf16;
typedef float f32x4 __attribute__((ext_vector_type(4)));
typedef short bf16x8 __attribute__((ext_vector_type(8)));
typedef short bf16x4 __attribute__((ext_vector_type(4)));
typedef unsigned u32x4 __attribute__((ext_vector_type(4)));
typedef unsigned u32x2 __attribute__((ext_vector_type(2)));
constexpr int NB = 8, SEQ = 4096, DM = 1024, MT = NB * SEQ;
constexpr int NIN = 3592, NPROJ = 3584, FF = 4096, PLE = 256;
__device__ __forceinline__ size_t qkv_off(int sect, int b, int h, int t) { return ((size_t)((sect * 8 + b) * 8 + h) * 4096 + t) * 64; }
__device__ __forceinline__ size_t mp_off(int sect, int b, int h, int t) { return ((size_t)((sect * 8 + b) * 4 + h) * 4096 + t) * 128; }
constexpr size_t MiB = 1u << 20;
constexpr size_t WS_WIN = 0, WS_WOUT = 7 * MiB, WS_WUP = 9 * MiB, WS_WDN = 17 * MiB, WS_WPG = 25 * MiB, WS_WPLE = 27 * MiB;
constexpr size_t WS_PB = 28 * MiB;
constexpr size_t WS_GATES = 44 * MiB;
constexpr size_t WS_SA = 45 * MiB, WS_SR = WS_SA + 512 * 1024, WS_SB = 46 * MiB, WS_SMC = WS_SB + 512 * 1024;
constexpr size_t WS_ROPE = 47 * MiB;
constexpr size_t WS_LSE = 48 * MiB;
constexpr size_t WS_NS = 51 * MiB;
constexpr size_t WS_SSQ1 = 52 * MiB, WS_SSQ2 = 54 * MiB, WS_SSQ3 = 56 * MiB;
constexpr size_t WS_CTL = 58 * MiB, CTL_BYTES = 16384;
constexpr size_t WS_MIX = 192 * MiB;
constexpr size_t WS_G = 256 * MiB, WS_GN = 264 * MiB;
constexpr size_t WS_QC = 64 * MiB, WS_KC = 96 * MiB;
constexpr size_t WS_BUFA = 64 * MiB;
constexpr size_t WS_BUFB = 128 * MiB;
constexpr size_t WS_QKV = 192 * MiB, WS_MP = 288 * MiB;
constexpr size_t WS_OP = 416 * MiB;
constexpr size_t WS_ACT = 192 * MiB;
constexpr size_t WS_END = 512 * MiB;
constexpr int LDS_BYTES = 147456, LDS_BAR_OFF = 143360;

__device__ __forceinline__ unsigned f2bf(float f) { unsigned u = __builtin_bit_cast(unsigned, f); return (u + 0x7fffu + ((u >> 16) & 1u)) >> 16; }
__device__ __forceinline__ unsigned pk2(float lo, float hi) { return pg8::cvt_pk_bf16(lo, hi); }
__device__ __forceinline__ float bflo(unsigned w) { return __builtin_bit_cast(float, w << 16); }
__device__ __forceinline__ float bfhi(unsigned w) { return __builtin_bit_cast(float, w & 0xffff0000u); }
__device__ __forceinline__ float wave_sum(float v) {
#pragma unroll
    for (int o = 32; o >= 1; o >>= 1) v += __shfl_xor(v, o);
    return v; }
#define MFMA16(a, b, c) __builtin_amdgcn_mfma_f32_16x16x32_bf16((a), (b), (c), 0, 0, 0)

struct Params { const float* in[16]; float* out; unsigned char* ws; int ph_lo, ph_hi; };

#define XB_TMO      128
#define XB_XCNT(j)  (256  + 64 * (j))
#define XB_XSUB(j)  (1280 + 64 * (j))
#define XB_XGEN(j)  (2304 + 64 * (j))
#define XB_TOP      3328
#define XB_TOPGEN   3392
#define XCD_BAR_WORDS 3456
#define XB_SPIN_CAP (1u << 18)

__device__ __forceinline__ unsigned xb_ld(unsigned* p)              { return __hip_atomic_load(p, __ATOMIC_RELAXED, __HIP_MEMORY_SCOPE_AGENT); }
__device__ __forceinline__ unsigned xb_add(unsigned* p, unsigned v) { return __hip_atomic_fetch_add(p, v, __ATOMIC_RELAXED, __HIP_MEMORY_SCOPE_AGENT); }
__device__ __forceinline__ unsigned xb_xcc_id() { return (unsigned)__builtin_amdgcn_s_getreg((3 << 11) | 20) & 0xFu; }
#define XB_SPIN(cond, bar) do { unsigned _sp = 0; while (cond) { __builtin_amdgcn_s_sleep(1); \
    if ((++_sp & 255u) == 0u) { if (xb_ld(&(bar)[XB_TMO])) break; if (_sp > XB_SPIN_CAP) { atomicAdd(&(bar)[XB_TMO], 1u); break; } } } } while (0)

struct XcdBarrier {
    unsigned* bar; unsigned x;
    volatile LAS unsigned* st;
};

__device__ __forceinline__ XcdBarrier xcd_barrier_post(unsigned* bar, volatile LAS unsigned* st) {
    XcdBarrier b; b.bar = bar; b.x = xb_xcc_id(); b.st = st;
    if (threadIdx.x == 0) (void)xb_add(&bar[XB_XCNT(b.x)], 1u);
    return b;
}
__device__ __forceinline__ void xcd_barrier_complete(unsigned* bar, unsigned x, unsigned& nloc, unsigned& nx) {
    const unsigned G = gridDim.x * gridDim.y * gridDim.z;
    unsigned sum, cnt, mine, sp = 0u;
    for (;;) {
        sum = 0u; cnt = 0u; mine = 0u;
#pragma unroll
        for (unsigned j = 0; j < 16; ++j) { const unsigned c = xb_ld(&bar[XB_XCNT(j)]); sum += c; cnt += (c > 0u) ? 1u : 0u; mine = (j == x) ? c : mine; }
        if (sum == G) break;
        __builtin_amdgcn_s_sleep(1);
        if ((++sp & 255u) == 0u) { if (xb_ld(&bar[XB_TMO])) break; if (sp > XB_SPIN_CAP) { atomicAdd(&bar[XB_TMO], 1u); break; } }
    }
    nloc = mine > 0u ? mine : 1u; nx = cnt > 0u ? cnt : 1u;
}

__device__ __forceinline__ void xcd_barrier(const XcdBarrier& b) {
    asm volatile("s_waitcnt vmcnt(0)" ::: "memory");
    __syncthreads();
    if (threadIdx.x == 0) {
        unsigned* bar = b.bar;
        __builtin_amdgcn_s_waitcnt(0);
        unsigned nloc = b.st[0], nx = b.st[1];
        if (nloc == 0u) { xcd_barrier_complete(bar, b.x, nloc, nx); b.st[0] = nloc; b.st[1] = nx; }
        const unsigned old = xb_add(&bar[XB_XSUB(b.x)], 1u);
        const unsigned gen = old / nloc;
        if (old + 1u == (gen + 1u) * nloc) {
            __builtin_amdgcn_fence(__ATOMIC_RELEASE, "agent");
            asm volatile("s_waitcnt vmcnt(0)" ::: "memory");
            const unsigned og = xb_add(&bar[XB_TOP], 1u);
            const unsigned tg = og / nx;
            if (og + 1u == (tg + 1u) * nx) xb_add(&bar[XB_TOPGEN], 1u);
            else XB_SPIN(xb_ld(&bar[XB_TOPGEN]) == tg, bar);
            __builtin_amdgcn_fence(__ATOMIC_ACQUIRE, "agent");
            xb_add(&bar[XB_XGEN(b.x)], 1u);
            asm volatile("s_waitcnt vmcnt(0)" ::: "memory");
        } else {
            XB_SPIN(xb_ld(&bar[XB_XGEN(b.x)]) == gen, bar);
            __builtin_amdgcn_fence(__ATOMIC_ACQUIRE, "agent");
            asm volatile("s_waitcnt vmcnt(0)" ::: "memory");
        }
    }
    __syncthreads();
}


struct TItem { const float* W; const float* g; bf16* Wt; int Nsrc, K, k0, n0; };
__device__ __forceinline__ TItem t_decode(const Params& P, int it) {
    constexpr int I_IN = 16 * 56, I_OUT = 16 * 16, I_UP = 16 * 64, I_DN = 64 * 16, I_PG = 16 * 16;
    unsigned char* ws = P.ws; TItem t; int r = it;
    if (r < I_IN) { t = TItem{P.in[3], nullptr, (bf16*)(ws + WS_WIN), NIN, 1024, (r & 15) * 64, (r >> 4) * 64}; return t; } r -= I_IN;
    if (r < I_OUT) { t = TItem{P.in[8], nullptr, (bf16*)(ws + WS_WOUT), 1024, 1024, (r & 15) * 64, (r >> 4) * 64}; return t; } r -= I_OUT;
    if (r < I_UP) { t = TItem{P.in[10], P.in[9], (bf16*)(ws + WS_WUP), 4096, 1024, (r & 15) * 64, (r >> 4) * 64}; return t; } r -= I_UP;
    if (r < I_DN) { t = TItem{P.in[11], nullptr, (bf16*)(ws + WS_WDN), 1024, 4096, (r & 63) * 64, (r >> 6) * 64}; return t; } r -= I_DN;
    if (r < I_PG) { t = TItem{P.in[13], P.in[12], (bf16*)(ws + WS_WPG), 1024, 1024, (r & 15) * 64, (r >> 4) * 64}; return t; } r -= I_PG;
    t = TItem{P.in[14], nullptr, (bf16*)(ws + WS_WPLE), 1024, 256, (r & 3) * 64, (r >> 2) * 64}; return t;
}
__device__ __forceinline__ void t_load(const TItem& t, f32x4 (&v)[2]) {
    const int tid = threadIdx.x;
#pragma unroll
    for (int pass = 0; pass < 2; ++pass) { const int kk = (tid >> 4) + pass * 32, nn = (tid & 15) * 4;
        v[pass] = *(const f32x4*)(t.W + (size_t)(t.k0 + kk) * t.Nsrc + t.n0 + nn); const float gs = t.g ? t.g[t.k0 + kk] : 1.0f; v[pass] = v[pass] * gs; }
}
__device__ __forceinline__ void t_store(const TItem& t, const f32x4 (&v)[2], LAS float* tile) {
    const int tid = threadIdx.x;
#pragma unroll
    for (int pass = 0; pass < 2; ++pass) { const int kk = (tid >> 4) + pass * 32, nn = (tid & 15) * 4;
        tile[kk * 65 + nn + 0] = v[pass][0]; tile[kk * 65 + nn + 1] = v[pass][1]; tile[kk * 65 + nn + 2] = v[pass][2]; tile[kk * 65 + nn + 3] = v[pass][3]; }
    __syncthreads();
    { const int n = tid >> 3, kc = (tid & 7) * 8; u32x4 w;
      w.x = pk2(tile[(kc + 0) * 65 + n], tile[(kc + 1) * 65 + n]); w.y = pk2(tile[(kc + 2) * 65 + n], tile[(kc + 3) * 65 + n]);
      w.z = pk2(tile[(kc + 4) * 65 + n], tile[(kc + 5) * 65 + n]); w.w = pk2(tile[(kc + 6) * 65 + n], tile[(kc + 7) * 65 + n]);
      *(u32x4*)(t.Wt + (size_t)(t.n0 + n) * t.K + t.k0 + kc) = w; }
    __syncthreads();
}
__device__ __forceinline__ float reduce8(float (&a)[8], int lane) {
    float b[4], c[2], d;
#pragma unroll
    for (int j = 0; j < 4; ++j) { const float keep = (lane & 1) ? a[2 * j + 1] : a[2 * j], send = (lane & 1) ? a[2 * j] : a[2 * j + 1]; b[j] = keep + __shfl_xor(send, 1); }
#pragma unroll
    for (int j = 0; j < 2; ++j) { const float keep = (lane & 2) ? b[2 * j + 1] : b[2 * j], send = (lane & 2) ? b[2 * j] : b[2 * j + 1]; c[j] = keep + __shfl_xor(send, 2); }
    { const float keep = (lane & 4) ? c[1] : c[0], send = (lane & 4) ? c[0] : c[1]; d = keep + __shfl_xor(send, 4); }
    d += __shfl_xor(d, 8); d += __shfl_xor(d, 16); d += __shfl_xor(d, 32);
    return d;
}
__device__ __forceinline__ void p0_prologue(const Params& P, LAS unsigned char* lds) {
    const int tid = threadIdx.x, lane = tid & 63, wave = tid >> 6, G = gridDim.x, bx = blockIdx.x;
    unsigned char* ws = P.ws;
    LAS float* tile = (LAS float*)lds;
    LAS float* wg = (LAS float*)(lds + 32768);
    { const float* w_in = P.in[3]; const float* gm = P.in[2];
      for (int k = tid; k < 1024; k += 512) { const f32x4 a = *(const f32x4*)(w_in + (size_t)k * NIN + NPROJ), c = *(const f32x4*)(w_in + (size_t)k * NIN + NPROJ + 4); const float gk = gm[k];
          wg[0 * 1024 + k] = a[0] * gk; wg[1 * 1024 + k] = a[1] * gk; wg[2 * 1024 + k] = a[2] * gk; wg[3 * 1024 + k] = a[3] * gk;
          wg[4 * 1024 + k] = c[0] * gk; wg[5 * 1024 + k] = c[1] * gk; wg[6 * 1024 + k] = c[2] * gk; wg[7 * 1024 + k] = c[3] * gk; } }
    { constexpr int NIT = 16 * 56 + 16 * 16 + 16 * 64 + 64 * 16 + 16 * 16 + 4 * 16;
      int it = bx;
      if (it < NIT) { TItem cur = t_decode(P, it); f32x4 v[2]; t_load(cur, v);
          for (;;) { const int nx = it + G; const bool has = nx < NIT; TItem nt = cur; f32x4 w[2] = {v[0], v[1]};
              if (has) { nt = t_decode(P, nx); t_load(nt, w); }
              t_store(cur, v, tile);
              if (!has) break;
              cur = nt; v[0] = w[0]; v[1] = w[1]; it = nx; } } }
    __syncthreads();
    { const float* x = P.in[0]; const float* gm = P.in[2]; const float* gate_b = P.in[6];
      bf16* U = (bf16*)(ws + WS_BUFA); float* GT = (float*)(ws + WS_GATES);
      f32x4 gv[4];
#pragma unroll
      for (int j = 0; j < 4; ++j) gv[j] = ((const f32x4*)gm)[lane + 64 * j];
      const float gb = gate_b[lane & 7];
      for (int row0 = (bx * 8 + wave) * 2; row0 < MT; row0 += G * 16) {
          f32x4 xv[2][4];
#pragma unroll
          for (int r = 0; r < 2; ++r)
#pragma unroll
              for (int j = 0; j < 4; ++j) xv[r][j] = ((const f32x4*)(x + (size_t)(row0 + r) * DM))[lane + 64 * j];
#pragma unroll
          for (int r = 0; r < 2; ++r) { const int row = row0 + r; float ss = 0.f;
#pragma unroll
              for (int j = 0; j < 4; ++j) ss += (xv[r][j][0] * xv[r][j][0] + xv[r][j][1] * xv[r][j][1]) + (xv[r][j][2] * xv[r][j][2] + xv[r][j][3] * xv[r][j][3]);
              ss = wave_sum(ss);
              const float rs = 1.0f / sqrtf(ss * (1.0f / DM) + 1e-6f);
#pragma unroll
              for (int j = 0; j < 4; ++j) { const f32x4 o = xv[r][j] * rs * gv[j]; u32x2 w; w.x = pk2(o[0], o[1]); w.y = pk2(o[2], o[3]);
                  *(u32x2*)(U + (size_t)row * DM + (lane + 64 * j) * 4) = w; }
              float ga[8];
#pragma unroll
              for (int gj = 0; gj < 8; ++gj) { float a = 0.f;
#pragma unroll
                  for (int j = 0; j < 4; ++j) { const f32x4 wv = ((const LAS f32x4*)(wg + gj * 1024))[lane + 64 * j]; a += (xv[r][j][0] * wv[0] + xv[r][j][1] * wv[1]) + (xv[r][j][2] * wv[2] + xv[r][j][3] * wv[3]); }
                  ga[gj] = a; }
              const float myg = reduce8(ga, lane);
              if (lane < 8) GT[(size_t)row * 8 + lane] = myg * rs + gb; }
      } }
    { const f32x4* p4 = (const f32x4*)P.in[1]; u32x2* pb = (u32x2*)(ws + WS_PB); const size_t n4 = (size_t)MT * PLE / 4, step = (size_t)G * 512;
      for (size_t i0 = (size_t)bx * 512 + tid; i0 < n4; i0 += 4 * step) { f32x4 v[4];
#pragma unroll
          for (int q = 0; q < 4; ++q) if (i0 + q * step < n4) v[q] = p4[i0 + q * step];
#pragma unroll
          for (int q = 0; q < 4; ++q) if (i0 + q * step < n4) { u32x2 w; w.x = pk2(v[q][0], v[q][1]); w.y = pk2(v[q][2], v[q][3]); pb[i0 + q * step] = w; } } }
    { float* rc = (float*)(ws + WS_ROPE); float* rsn = rc + 4096 * 8;
      for (int i = bx * 512 + tid; i < 4096 * 8; i += G * 512) { const int pos = i >> 3, f = i & 7; const float inv = powf(500000.0f, -(float)f * 0.125f); const float ang = (float)pos * inv;
          rc[i] = cosf(ang); rsn[i] = sinf(ang); } }
}

__device__ __forceinline__ void gate_scan(const Params& P, int bh, LAS unsigned char* lds) {
    const int tid = threadIdx.x, lane = tid & 63, wave = tid >> 6; const int b = bh >> 2, h = bh & 3;
    unsigned char* ws = P.ws; const float* GT = (const float*)(ws + WS_GATES);
    float* SA = (float*)(ws + WS_SA); float* SR = (float*)(ws + WS_SR); float* SB = (float*)(ws + WS_SB); float* SMC = (float*)(ws + WS_SMC);
    LAS float* sm = (LAS float*)lds;
    float a_[8], b_[8], cm_[8];
#pragma unroll
    for (int j = 0; j < 8; ++j) { const int c = wave + 8 * j, t = c * 64 + lane; const float* gp = GT + (size_t)(b * SEQ + t) * 8;
        const float ip = gp[h], fp = gp[4 + h];
        const float lf = fminf(fp, 0.f) - log1pf(expf(-fabsf(fp)));
        float s = lf;
#pragma unroll
        for (int o = 1; o < 64; o <<= 1) { const float v = __shfl_up(s, o); if (lane >= o) s += v; }
        const float a = ip - s; float cm = a;
#pragma unroll
        for (int o = 1; o < 64; o <<= 1) { const float v = __shfl_up(cm, o); if (lane >= o) cm = fmaxf(cm, v); }
        a_[j] = a; b_[j] = s; cm_[j] = cm;
        if (lane == 63) { sm[c] = s; sm[64 + c] = cm; } }
    __syncthreads();
    if (tid < 64) {
        const float blv = sm[lane], amv = sm[64 + lane]; float m = 0.f, mcv = 0.f;
#pragma unroll 8
        for (int c = 0; c < 64; ++c) { mcv = (lane == c) ? m : mcv;
            m = __builtin_bit_cast(float, __builtin_amdgcn_readlane(__builtin_bit_cast(int, blv), c)) + fmaxf(m, __builtin_bit_cast(float, __builtin_amdgcn_readlane(__builtin_bit_cast(int, amv), c))); }
        sm[128 + lane] = mcv; }
    __syncthreads();
#pragma unroll
    for (int j = 0; j < 8; ++j) { const int c = wave + 8 * j, t = c * 64 + lane; const float mc = sm[128 + c];
        SA[bh * SEQ + t] = a_[j]; SR[bh * SEQ + t] = fmaxf(mc, cm_[j]); SB[bh * SEQ + t] = b_[j]; if (lane == 0) SMC[bh * 64 + c] = mc; }
    __syncthreads();
}

constexpr int AQ_STRIDE = 144, AV_STRIDE = 792;
constexpr int A_Q0 = 0, A_QB = 128 * AQ_STRIDE, A_KOFF = 2 * A_QB, A_KSLOT = 128 * AQ_STRIDE, A_VOFF = A_KOFF + 3 * A_KSLOT;
struct AttnItem { int pi, b, h, r, n, dsh; };
__device__ __forceinline__ AttnItem attn_decode(int it) { AttnItem a; const int bh = it / 96, rem = it - bh * 96, jj = rem & 31; a.pi = rem >> 5; a.b = bh >> 3; a.h = bh & 7; a.dsh = 2 * a.pi;
    const int nbsh = 5 - 2 * a.pi; a.r = jj >> nbsh; a.n = jj & ((1 << nbsh) - 1); return a; }
struct AttnRegs { u32x4 q0, q1, k0, k1, va, vb; };
__device__ __forceinline__ void attn_load_kv(const bf16* proj, const AttnItem& a, int nblk, AttnRegs& R) {
    const int tid = threadIdx.x, qi = tid >> 2, dc = tid & 3, kp = tid & 63, dg = tid >> 6;
    const int pos = ((nblk * 128 + qi) << a.dsh) + a.r; const bf16* ks = proj + qkv_off(1, a.b, a.h, pos) + dc * 16;
    R.k0 = *(const u32x4*)ks; R.k1 = *(const u32x4*)(ks + 8);
    const bf16* vs = proj + qkv_off(2, a.b, a.h, pos) + dc * 16;
    R.va = *(const u32x4*)vs; R.vb = *(const u32x4*)(vs + 8);
}
__device__ __forceinline__ void attn_load_q(const bf16* proj, const AttnItem& a, AttnRegs& R) {
    const int tid = threadIdx.x, qi = tid >> 2, dc = tid & 3; const int pos = ((a.n * 128 + qi) << a.dsh) + a.r;
    const bf16* qs = proj + qkv_off(0, a.b, a.h, pos) + dc * 16; R.q0 = *(const u32x4*)qs; R.q1 = *(const u32x4*)(qs + 8);
}
__device__ __forceinline__ void attn_commit_kv(LAS unsigned char* lds, int slot, const AttnRegs& R) {
    const int tid = threadIdx.x, qi = tid >> 2, dc = tid & 3, kp = tid & 63, dg = tid >> 6;
    *(LAS u32x4*)(lds + A_KOFF + slot * A_KSLOT + qi * AQ_STRIDE + dc * 32) = R.k0; *(LAS u32x4*)(lds + A_KOFF + slot * A_KSLOT + qi * AQ_STRIDE + dc * 32 + 16) = R.k1;
    { const int odd = qi & 1, kp2 = qi >> 1;
      const u32x4 snd = odd ? R.va : R.vb; u32x4 rcv;
      rcv.x = __shfl_xor(snd.x, 4); rcv.y = __shfl_xor(snd.y, 4); rcv.z = __shfl_xor(snd.z, 4); rcv.w = __shfl_xor(snd.w, 4);
      const u32x4 ka = odd ? rcv : R.va, kb = odd ? R.vb : rcv;
      LAS unsigned char* vt = lds + A_VOFF + (dc * 16 + odd * 8) * AV_STRIDE + slot * 256 + kp2 * 4;
      *(LAS unsigned*)(vt + 0 * AV_STRIDE) = (ka.x & 0xffffu) | (kb.x << 16); *(LAS unsigned*)(vt + 1 * AV_STRIDE) = (ka.x >> 16) | (kb.x & 0xffff0000u);
      *(LAS unsigned*)(vt + 2 * AV_STRIDE) = (ka.y & 0xffffu) | (kb.y << 16); *(LAS unsigned*)(vt + 3 * AV_STRIDE) = (ka.y >> 16) | (kb.y & 0xffff0000u);
      *(LAS unsigned*)(vt + 4 * AV_STRIDE) = (ka.z & 0xffffu) | (kb.z << 16); *(LAS unsigned*)(vt + 5 * AV_STRIDE) = (ka.z >> 16) | (kb.z & 0xffff0000u);
      *(LAS unsigned*)(vt + 6 * AV_STRIDE) = (ka.w & 0xffffu) | (kb.w << 16); *(LAS unsigned*)(vt + 7 * AV_STRIDE) = (ka.w >> 16) | (kb.w & 0xffff0000u); }
}
__device__ __forceinline__ void attn_commit_q(LAS unsigned char* lds, int qb, const AttnRegs& R) {
    const int tid = threadIdx.x, qi = tid >> 2, dc = tid & 3;
    *(LAS u32x4*)(lds + A_Q0 + qb * A_QB + qi * AQ_STRIDE + dc * 32) = R.q0; *(LAS u32x4*)(lds + A_Q0 + qb * A_QB + qi * AQ_STRIDE + dc * 32 + 16) = R.q1;
}
__device__ __forceinline__ void attn_compute(const Params& P, const AttnItem& a, int qb, int sprev, int scur, LAS unsigned char* lds) {
    const int tid = threadIdx.x, lane = tid & 63, wave = tid >> 6, fr = lane & 15, g = lane >> 4; unsigned char* ws = P.ws; const int n = a.n;
    const int q0 = wave * 16;
    bf16x8 qf[2];
#pragma unroll
    for (int ks = 0; ks < 2; ++ks) qf[ks] = *(const LAS bf16x8*)(lds + A_Q0 + qb * A_QB + (q0 + fr) * AQ_STRIDE + ks * 64 + g * 16);
    f32x4 sc[9];
    __builtin_amdgcn_s_setprio(1);
#pragma unroll
    for (int nt = 0; nt < 9; ++nt) { f32x4 acc = (f32x4){0.f, 0.f, 0.f, 0.f}; const int ki0 = q0 + 16 * nt; const int slot = (ki0 < 128) ? sprev : scur;
#pragma unroll
        for (int ks = 0; ks < 2; ++ks) { const bf16x8 kf = *(const LAS bf16x8*)(lds + A_KOFF + slot * A_KSLOT + ((ki0 & 127) + fr) * AQ_STRIDE + ks * 64 + g * 16); acc = MFMA16(kf, qf[ks], acc); }
        sc[nt] = acc; }
    __builtin_amdgcn_s_setprio(0);
    const float SC2 = 0.125f * 1.4426950408889634f;
    float mx = -INFINITY;
#pragma unroll
    for (int nt = 0; nt < 9; ++nt) { const bool tile_ok = (n > 0) || (q0 + 16 * nt >= 128);
#pragma unroll
        for (int i = 0; i < 4; ++i) { bool ok = tile_ok; if (nt == 0) ok = ok && (4 * g + i >= fr); if (nt == 8) ok = ok && (4 * g + i <= fr);
            const float sv = ok ? sc[nt][i] * SC2 : -INFINITY; sc[nt][i] = sv; mx = fmaxf(mx, sv); } }
    mx = fmaxf(mx, __shfl_xor(mx, 16)); mx = fmaxf(mx, __shfl_xor(mx, 32));
    float den = 0.f;
#pragma unroll
    for (int nt = 0; nt < 9; ++nt)
#pragma unroll
        for (int i = 0; i < 4; ++i) { const float p = __builtin_amdgcn_exp2f(sc[nt][i] - mx); sc[nt][i] = p; den += p; }
    den += __shfl_xor(den, 16); den += __shfl_xor(den, 32);
    bf16x8 pf[5];
#pragma unroll
    for (int ks = 0; ks < 5; ++ks) { u32x4 w; w.x = pg8::cvt_pk_bf16(sc[2 * ks][0], sc[2 * ks][1]); w.y = pg8::cvt_pk_bf16(sc[2 * ks][2], sc[2 * ks][3]);
        if (ks < 4) { w.z = pg8::cvt_pk_bf16(sc[2 * ks + 1][0], sc[2 * ks + 1][1]); w.w = pg8::cvt_pk_bf16(sc[2 * ks + 1][2], sc[2 * ks + 1][3]); } else { w.z = 0u; w.w = 0u; }
        pf[ks] = __builtin_bit_cast(bf16x8, w); }
    const float inv = __builtin_amdgcn_rcpf(den);
    const int posq = ((n * 128 + q0 + fr) << a.dsh) + a.r; const size_t tokbase = (size_t)a.b * SEQ;
    bf16* OP = (bf16*)(ws + WS_OP) + (size_t)a.pi * MT * 512 + (tokbase + posq) * 512 + a.h * 64;
    __builtin_amdgcn_s_setprio(1);
#pragma unroll
    for (int et = 0; et < 4; ++et) { f32x4 o = (f32x4){0.f, 0.f, 0.f, 0.f};
#pragma unroll
        for (int ks = 0; ks < 5; ++ks) { const int kb0 = q0 + 32 * ks, kb1 = kb0 + 16;
            const LAS unsigned char* vrow = lds + A_VOFF + (et * 16 + fr) * AV_STRIDE + (4 * g) * 2;
            const u32x2 v0 = *(const LAS u32x2*)(vrow + ((kb0 < 128) ? sprev : scur) * 256 + (kb0 & 127) * 2); u32x2 v1 = (u32x2){0u, 0u};
            if (ks < 4) v1 = *(const LAS u32x2*)(vrow + ((kb1 < 128) ? sprev : scur) * 256 + (kb1 & 127) * 2);
            const u32x4 vw = (u32x4){v0.x, v0.y, v1.x, v1.y};
            o = MFMA16(__builtin_bit_cast(bf16x8, vw), pf[ks], o); }
        u32x2 w; w.x = pg8::cvt_pk_bf16(o[0] * inv, o[1] * inv); w.y = pg8::cvt_pk_bf16(o[2] * inv, o[3] * inv);
        *(u32x2*)(OP + et * 16 + 4 * g) = w; }
    __builtin_amdgcn_s_setprio(0);
    if (g == 0) ((float*)(ws + WS_LSE))[(size_t)a.pi * MT * 8 + (tokbase + posq) * 8 + a.h] = mx * 0.6931471805599453f + logf(den);
}
__device__ __forceinline__ void attn_phase(const Params& P, LAS unsigned char* lds) {
    const int G = gridDim.x, per = (6144 + G - 1) / G; const int bxv = (G % 8 == 0) ? (blockIdx.x & 7) * (G / 8) + (blockIdx.x >> 3) : blockIdx.x;
    const int it0 = bxv * per, it1 = (it0 + per < 6144) ? it0 + per : 6144;
    if (it0 >= it1) return;
    const bf16* proj = (const bf16*)(P.ws + WS_QKV);
    AttnRegs RA, RB;
    { const AttnItem a = attn_decode(it0);
      if (a.n > 0) { attn_load_kv(proj, a, a.n - 1, RA); attn_commit_kv(lds, 2, RA); }
      else { RA.k0 = (u32x4){0u, 0u, 0u, 0u}; RA.k1 = RA.k0; RA.va = RA.k0; RA.vb = RA.k0; attn_commit_kv(lds, 2, RA); }
      attn_load_kv(proj, a, a.n, RA); attn_load_q(proj, a, RA); attn_commit_kv(lds, 0, RA); attn_commit_q(lds, 0, RA); }
    if (it0 + 1 < it1) { const AttnItem an = attn_decode(it0 + 1); attn_load_kv(proj, an, an.n, RA); attn_load_q(proj, an, RA); }
    __syncthreads();
    int i3 = 0;
    for (int it = it0; it < it1; it += 2) {
        { const AttnItem a = attn_decode(it);
          if (it + 2 < it1) { const AttnItem an = attn_decode(it + 2); attn_load_kv(proj, an, an.n, RB); attn_load_q(proj, an, RB); }
          const int scur = i3, sprev = (i3 == 0) ? 2 : i3 - 1, snext = (i3 == 2) ? 0 : i3 + 1;
          attn_compute(P, a, 0, sprev, scur, lds);
          if (it + 1 < it1) { attn_commit_kv(lds, snext, RA); attn_commit_q(lds, 1, RA); }
          __syncthreads();
          i3 = snext; }
        if (it + 1 >= it1) break;
        { const AttnItem a = attn_decode(it + 1);
          if (it + 3 < it1) { const AttnItem an = attn_decode(it + 3); attn_load_kv(proj, an, an.n, RA); attn_load_q(proj, an, RA); }
          const int scur = i3, sprev = (i3 == 0) ? 2 : i3 - 1, snext = (i3 == 2) ? 0 : i3 + 1;
          attn_compute(P, a, 1, sprev, scur, lds);
          if (it + 2 < it1) { attn_commit_kv(lds, snext, RB); attn_commit_q(lds, 0, RB); }
          __syncthreads();
          i3 = snext; }
    }
}

__device__ __forceinline__ void conv_silu2(const u32x4 (&xr)[5], const float* cw  , const float* cb, int ch, float scale, float (&o0)[8], float (&o1)[8]) {
    float xv[5][8];
#pragma unroll
    for (int i = 0; i < 5; ++i) { xv[i][0] = bflo(xr[i].x); xv[i][1] = bfhi(xr[i].x); xv[i][2] = bflo(xr[i].y); xv[i][3] = bfhi(xr[i].y); xv[i][4] = bflo(xr[i].z); xv[i][5] = bfhi(xr[i].z); xv[i][6] = bflo(xr[i].w); xv[i][7] = bfhi(xr[i].w); }
    float wv[4][8], bv[8];
#pragma unroll
    for (int j = 0; j < 4; ++j) { const f32x4 a = *(const f32x4*)(cw + j * 1024 + ch), c = *(const f32x4*)(cw + j * 1024 + ch + 4);
        wv[j][0] = a[0]; wv[j][1] = a[1]; wv[j][2] = a[2]; wv[j][3] = a[3]; wv[j][4] = c[0]; wv[j][5] = c[1]; wv[j][6] = c[2]; wv[j][7] = c[3]; }
    { const f32x4 a = *(const f32x4*)(cb + ch), c = *(const f32x4*)(cb + ch + 4); bv[0] = a[0]; bv[1] = a[1]; bv[2] = a[2]; bv[3] = a[3]; bv[4] = c[0]; bv[5] = c[1]; bv[6] = c[2]; bv[7] = c[3]; }
#pragma unroll
    for (int e = 0; e < 8; ++e) {
        float s0 = bv[e], s1 = bv[e];
#pragma unroll
        for (int j = 0; j < 4; ++j) { s0 += wv[j][e] * xv[j][e]; s1 += wv[j][e] * xv[j + 1][e]; }
        o0[e] = s0 * __builtin_amdgcn_rcpf(1.0f + __expf(-s0)) * scale; o1[e] = s1 * __builtin_amdgcn_rcpf(1.0f + __expf(-s1)) * scale; }
}
__device__ __forceinline__ void conv_silu4(const u32x4 (&xr)[7], const float* cw  , const float* cb, int ch, float scale, float (&o)[4][8]) {
    float wv[4][8], bv[8];
#pragma unroll
    for (int j = 0; j < 4; ++j) { const f32x4 a = *(const f32x4*)(cw + j * 1024 + ch), c = *(const f32x4*)(cw + j * 1024 + ch + 4);
        wv[j][0] = a[0]; wv[j][1] = a[1]; wv[j][2] = a[2]; wv[j][3] = a[3]; wv[j][4] = c[0]; wv[j][5] = c[1]; wv[j][6] = c[2]; wv[j][7] = c[3]; }
    { const f32x4 a = *(const f32x4*)(cb + ch), c = *(const f32x4*)(cb + ch + 4); bv[0] = a[0]; bv[1] = a[1]; bv[2] = a[2]; bv[3] = a[3]; bv[4] = c[0]; bv[5] = c[1]; bv[6] = c[2]; bv[7] = c[3]; }
    float xv[7][8];
#pragma unroll
    for (int i = 0; i < 7; ++i) { xv[i][0] = bflo(xr[i].x); xv[i][1] = bfhi(xr[i].x); xv[i][2] = bflo(xr[i].y); xv[i][3] = bfhi(xr[i].y); xv[i][4] = bflo(xr[i].z); xv[i][5] = bfhi(xr[i].z); xv[i][6] = bflo(xr[i].w); xv[i][7] = bfhi(xr[i].w); }
#pragma unroll
    for (int t = 0; t < 4; ++t)
#pragma unroll
        for (int e = 0; e < 8; ++e) { float a = bv[e];
#pragma unroll
            for (int j = 0; j < 4; ++j) a += wv[j][e] * xv[t + j][e];
            o[t][e] = a * __builtin_amdgcn_rcpf(1.0f + __expf(-a)) * scale; }
}
__device__ __forceinline__ void load7(const bf16* mp, int sect, int b, int h, int t0, int ch, u32x4 (&xr)[7]) {
    const bf16* base = mp + mp_off(sect, b, h, 0) + ch;
#pragma unroll
    for (int i = 0; i < 7; ++i) { const int t = t0 - 3 + i; xr[i] = (u32x4){0u, 0u, 0u, 0u};
        if (t >= 0) xr[i] = *(const u32x4*)(base + (size_t)t * 128); }
}
__device__ __forceinline__ void load5(const bf16* mp, int sect, int b, int h, int t0, int ch, u32x4 (&xr)[5]) {
    const bf16* base = mp + mp_off(sect, b, h, 0) + ch;
#pragma unroll
    for (int i = 0; i < 5; ++i) { const int t = t0 - 3 + i; xr[i] = (u32x4){0u, 0u, 0u, 0u};
        if (t >= 0) xr[i] = *(const u32x4*)(base + (size_t)t * 128); }
}
constexpr int T72 = 144, T136 = 272;
__device__ __forceinline__ void stage_vt(const bf16* proj, int b, int h, int t0, LAS unsigned char* vt) {
    const int tid = threadIdx.x, eg = tid >> 5, tg = tid & 31;
    const bf16* s0 = proj + mp_off(2, b, h, t0 + 2 * tg) + eg * 8;
    const u32x4 va = *(const u32x4*)s0, vb = *(const u32x4*)(s0 + 128);
    LAS unsigned char* d = vt + (eg * 8) * T72 + tg * 4;
    *(LAS unsigned*)(d + 0 * T72) = (va.x & 0xffffu) | (vb.x << 16); *(LAS unsigned*)(d + 1 * T72) = (va.x >> 16) | (vb.x & 0xffff0000u);
    *(LAS unsigned*)(d + 2 * T72) = (va.y & 0xffffu) | (vb.y << 16); *(LAS unsigned*)(d + 3 * T72) = (va.y >> 16) | (vb.y & 0xffff0000u);
    *(LAS unsigned*)(d + 4 * T72) = (va.z & 0xffffu) | (vb.z << 16); *(LAS unsigned*)(d + 5 * T72) = (va.z >> 16) | (vb.z & 0xffff0000u);
    *(LAS unsigned*)(d + 6 * T72) = (va.w & 0xffffu) | (vb.w << 16); *(LAS unsigned*)(d + 7 * T72) = (va.w >> 16) | (vb.w & 0xffff0000u);
}

struct LBig { u32x4 xr[7], va, vb; };
__device__ __forceinline__ void mlstm_local_load(const Params& P, int item, LBig& R) {
    const int tid = threadIdx.x; const int bh = item >> 6, c = item & 63, b = bh >> 2, h = bh & 3, t0 = c * 64; const bf16* proj = (const bf16*)(P.ws + WS_MP);
    if (tid < 256) { const int cgp = tid & 15, tg = tid >> 4; load7(proj, 0, b, h, t0 + 4 * tg, cgp * 8, R.xr); }
    else { const int idx = tid - 256, tg = idx & 15, cgp = idx >> 4; load7(proj, 1, b, h, t0 + 4 * tg, cgp * 8, R.xr); }
    { const int eg = tid >> 5, tg = tid & 31; const bf16* s0 = proj + mp_off(2, b, h, t0 + 2 * tg) + eg * 8; R.va = *(const u32x4*)s0; R.vb = *(const u32x4*)(s0 + 128); }
}
__device__ __forceinline__ void mlstm_local_item(const Params& P, int item, int next, bool first, float& nrun, LBig& R, LAS unsigned char* lds) {
    const int tid = threadIdx.x, lane = tid & 63, wave = tid >> 6, fr = lane & 15, g = lane >> 4;
    const int bh = item >> 6, c = item & 63, b = bh >> 2, h = bh & 3;
    unsigned char* ws = P.ws;
    const float* SA = (const float*)(ws + WS_SA); const float* SR = (const float*)(ws + WS_SR);
    LAS unsigned char* kwt = lds; LAS unsigned char* vt = lds + 128 * T72;
    const int t0 = c * 64;
    if (tid < 256) {
        const int cgp = tid & 15, tg = tid >> 4;
        float o[4][8]; conv_silu4(R.xr, P.in[4], P.in[5], h * 128 + cgp * 8, 1.0f, o);
        bf16* qc = (bf16*)(ws + WS_QC) + mp_off(0, b, h, t0 + 4 * tg) + cgp * 8;
#pragma unroll
        for (int t = 0; t < 4; ++t) { u32x4 w; w.x = pk2(o[t][0], o[t][1]); w.y = pk2(o[t][2], o[t][3]); w.z = pk2(o[t][4], o[t][5]); w.w = pk2(o[t][6], o[t][7]); *(u32x4*)(qc + t * 128) = w; }
    } else {
        const int idx = tid - 256, tg = idx & 15, cgp = idx >> 4;
        const f32x4 av = *(const f32x4*)(SA + bh * SEQ + t0 + 4 * tg); const float rl = SR[bh * SEQ + t0 + 63];
        float o[4][8]; conv_silu4(R.xr, P.in[4], P.in[5], 512 + h * 128 + cgp * 8, 0.08838834764831845f, o);
        bf16* kc = (bf16*)(ws + WS_KC) + mp_off(0, b, h, t0 + 4 * tg) + cgp * 8;
#pragma unroll
        for (int t = 0; t < 4; ++t) { u32x4 w; w.x = pk2(o[t][0], o[t][1]); w.y = pk2(o[t][2], o[t][3]); w.z = pk2(o[t][4], o[t][5]); w.w = pk2(o[t][6], o[t][7]); *(u32x4*)(kc + t * 128) = w; }
        const float w0 = __expf(av[0] - rl), w1 = __expf(av[1] - rl), w2 = __expf(av[2] - rl), w3 = __expf(av[3] - rl);
        LAS unsigned char* d = kwt + (cgp * 8) * T72 + tg * 8;
#pragma unroll
        for (int e = 0; e < 8; ++e) { u32x2 w; w.x = pk2(o[0][e] * w0, o[1][e] * w1); w.y = pk2(o[2][e] * w2, o[3][e] * w3); *(LAS u32x2*)(d + e * T72) = w; }
    }
    { const int eg = tid >> 5, tg = tid & 31; LAS unsigned char* d = vt + (eg * 8) * T72 + tg * 4; const u32x4 va = R.va, vb = R.vb;
      *(LAS unsigned*)(d + 0 * T72) = (va.x & 0xffffu) | (vb.x << 16); *(LAS unsigned*)(d + 1 * T72) = (va.x >> 16) | (vb.x & 0xffff0000u);
      *(LAS unsigned*)(d + 2 * T72) = (va.y & 0xffffu) | (vb.y << 16); *(LAS unsigned*)(d + 3 * T72) = (va.y >> 16) | (vb.y & 0xffff0000u);
      *(LAS unsigned*)(d + 4 * T72) = (va.z & 0xffffu) | (vb.z << 16); *(LAS unsigned*)(d + 5 * T72) = (va.z >> 16) | (vb.z & 0xffff0000u);
      *(LAS unsigned*)(d + 6 * T72) = (va.w & 0xffffu) | (vb.w << 16); *(LAS unsigned*)(d + 7 * T72) = (va.w >> 16) | (vb.w & 0xffff0000u); }
    __syncthreads();
    if (next >= 0) mlstm_local_load(P, next, R);
    const float dcy = first ? 0.f : __expf(((const float*)(ws + WS_SMC))[bh * 64 + c] - SR[bh * SEQ + t0 + 63]);
    if (tid < 128) { float s = 0.f;
#pragma unroll
        for (int q = 0; q < 8; ++q) { const u32x4 w = *(const LAS u32x4*)(kwt + tid * T72 + q * 16); s += (bflo(w.x) + bfhi(w.x)) + (bflo(w.y) + bfhi(w.y)) + (bflo(w.z) + bfhi(w.z)) + (bflo(w.w) + bfhi(w.w)); }
        nrun = dcy * nrun + s;
        ((float*)(ws + WS_NS))[(size_t)item * 128 + tid] = nrun; }
    bf16x8 vf[2];
#pragma unroll
    for (int ks = 0; ks < 2; ++ks) vf[ks] = *(const LAS bf16x8*)(vt + (wave * 16 + fr) * T72 + ks * 64 + g * 16);
    bf16* ST = (bf16*)(ws + WS_BUFB) + (size_t)item * 16384 + (wave * 16 + fr) * 128;
#pragma unroll
    for (int dt = 0; dt < 8; ++dt) { LAS f32x4* sp = (LAS f32x4*)(lds + 40960 + ((wave * 8 + dt) * 64 + lane) * 16);
        f32x4 a = (f32x4){0.f, 0.f, 0.f, 0.f}; if (!first) a = *sp * dcy;
#pragma unroll
        for (int ks = 0; ks < 2; ++ks) { const bf16x8 kf = *(const LAS bf16x8*)(kwt + (dt * 16 + fr) * T72 + ks * 64 + g * 16); a = MFMA16(kf, vf[ks], a); }
        *sp = a;
        u32x2 w; w.x = pk2(a[0], a[1]); w.y = pk2(a[2], a[3]);
        *(u32x2*)(ST + dt * 16 + 4 * g) = w; }
    __syncthreads();
}

__device__ __forceinline__ void mlstm_scan(const Params& P) {
    unsigned char* ws = P.ws; const float* SR = (const float*)(ws + WS_SR); const float* SMC = (const float*)(ws + WS_SMC);
    const int G = gridDim.x;
    for (int gid = blockIdx.x * 512 + threadIdx.x; gid < 32 * 4096; gid += G * 512) {
        const int bh = gid >> 12, e4 = gid & 4095;
        const u32x2* st = (const u32x2*)((const bf16*)(ws + WS_BUFB) + (size_t)bh * 64 * 16384) + e4;
        u32x2* gb = (u32x2*)((bf16*)(ws + WS_G) + (size_t)bh * 8 * 16384) + e4;
        const bool has_n = e4 < 128; const float* ns = (const float*)(ws + WS_NS) + (size_t)bh * 64 * 128 + (has_n ? e4 : 0); float* gn = (float*)(ws + WS_GN) + (size_t)bh * 8 * 128 + (has_n ? e4 : 0);
        u32x2 u[7]; float un[7], D[7];
#pragma unroll
        for (int g = 0; g < 7; ++g) { u[g] = st[(size_t)(8 * g + 7) * 4096]; un[g] = has_n ? ns[(8 * g + 7) * 128] : 0.f; float ld = 0.f;
#pragma unroll
            for (int q = 0; q < 8; ++q) ld += SMC[bh * 64 + 8 * g + q] - SR[bh * SEQ + (8 * g + q) * 64 + 63];
            D[g] = __expf(ld); }
        float s0 = 0.f, s1 = 0.f, s2 = 0.f, s3 = 0.f, sn = 0.f;
#pragma unroll
        for (int g = 0; g < 7; ++g) { s0 = D[g] * s0 + bflo(u[g].x); s1 = D[g] * s1 + bfhi(u[g].x); s2 = D[g] * s2 + bflo(u[g].y); s3 = D[g] * s3 + bfhi(u[g].y);
            u32x2 w; w.x = pk2(s0, s1); w.y = pk2(s2, s3); gb[(size_t)(g + 1) * 4096] = w;
            sn = D[g] * sn + un[g]; if (has_n) gn[(g + 1) * 128] = sn; }
    }
}

constexpr int M_QOFF = 0, M_KOFF = 64 * T136, M_VOFF = 2 * 64 * T136, M_COFF = M_VOFF + 128 * T72, M_NOFF = M_COFF + 128 * T136, M_SOFF = M_NOFF + 512, M_GOFF = 90112, M_GNOFF = M_GOFF + 32768;
struct MBig { u32x4 q[2], k[2], va, vb, c[4]; float nv, eL; };
__device__ __forceinline__ void mlstm_out_load(const Params& P, int item, MBig& R) {
    const int tid = threadIdx.x; const int bh = item >> 6, c = item & 63, b = bh >> 2, h = bh & 3, t0 = c * 64; unsigned char* ws = P.ws;
    const bf16* qc = (const bf16*)(ws + WS_QC) + mp_off(0, b, h, t0); const bf16* kc = (const bf16*)(ws + WS_KC) + mp_off(0, b, h, t0);
#pragma unroll
    for (int i = 0; i < 2; ++i) { const int ch = tid + 512 * i, row = ch >> 4, q = ch & 15; R.q[i] = *(const u32x4*)(qc + row * 128 + q * 8); R.k[i] = *(const u32x4*)(kc + row * 128 + q * 8); }
    { const int eg = tid >> 5, tg = tid & 31; const bf16* s0 = (const bf16*)(ws + WS_MP) + mp_off(2, b, h, t0 + 2 * tg) + eg * 8; R.va = *(const u32x4*)s0; R.vb = *(const u32x4*)(s0 + 128); }
    const int grp = c >> 3, jg = c & 7;
    const bf16* ST = (const bf16*)(ws + WS_BUFB) + (size_t)(item - 1) * 16384;
#pragma unroll
    for (int i = 0; i < 4; ++i) { const int ch = tid + 512 * i, e = ch >> 4, q = ch & 15; R.c[i] = (u32x4){0u, 0u, 0u, 0u};
        if (jg > 0) R.c[i] = *(const u32x4*)(ST + e * 128 + q * 8); }
    R.nv = (jg > 0 && tid < 128) ? ((const float*)(ws + WS_NS))[(size_t)(item - 1) * 128 + tid] : 0.f;
    { const float* SR = (const float*)(ws + WS_SR); const float* SMC = (const float*)(ws + WS_SMC); float ld = 0.f;
      for (int q = 0; q < jg; ++q) ld += SMC[bh * 64 + 8 * grp + q] - SR[bh * SEQ + (8 * grp + q) * 64 + 63];
      R.eL = __expf(ld); }
}
__device__ __forceinline__ void mlstm_out_stage(const MBig& R, LAS unsigned char* lds) {
    const int tid = threadIdx.x;
#pragma unroll
    for (int i = 0; i < 2; ++i) { const int ch = tid + 512 * i, row = ch >> 4, q = ch & 15; *(LAS u32x4*)(lds + M_QOFF + row * T136 + q * 16) = R.q[i]; *(LAS u32x4*)(lds + M_KOFF + row * T136 + q * 16) = R.k[i]; }
    { const int eg = tid >> 5, tg = tid & 31; LAS unsigned char* d = lds + M_VOFF + (eg * 8) * T72 + tg * 4; const u32x4 va = R.va, vb = R.vb;
      *(LAS unsigned*)(d + 0 * T72) = (va.x & 0xffffu) | (vb.x << 16); *(LAS unsigned*)(d + 1 * T72) = (va.x >> 16) | (vb.x & 0xffff0000u);
      *(LAS unsigned*)(d + 2 * T72) = (va.y & 0xffffu) | (vb.y << 16); *(LAS unsigned*)(d + 3 * T72) = (va.y >> 16) | (vb.y & 0xffff0000u);
      *(LAS unsigned*)(d + 4 * T72) = (va.z & 0xffffu) | (vb.z << 16); *(LAS unsigned*)(d + 5 * T72) = (va.z >> 16) | (vb.z & 0xffff0000u);
      *(LAS unsigned*)(d + 6 * T72) = (va.w & 0xffffu) | (vb.w << 16); *(LAS unsigned*)(d + 7 * T72) = (va.w >> 16) | (vb.w & 0xffff0000u); }
    const float eL = R.eL;
#pragma unroll
    for (int i = 0; i < 4; ++i) { const int ch = tid + 512 * i, e = ch >> 4, q = ch & 15; const u32x4 a = R.c[i], gq = *(const LAS u32x4*)(lds + M_GOFF + ch * 16); u32x4 w;
        w.x = pk2(bflo(a.x) + eL * bflo(gq.x), bfhi(a.x) + eL * bfhi(gq.x)); w.y = pk2(bflo(a.y) + eL * bflo(gq.y), bfhi(a.y) + eL * bfhi(gq.y));
        w.z = pk2(bflo(a.z) + eL * bflo(gq.z), bfhi(a.z) + eL * bfhi(gq.z)); w.w = pk2(bflo(a.w) + eL * bflo(gq.w), bfhi(a.w) + eL * bfhi(gq.w));
        *(LAS u32x4*)(lds + M_COFF + e * T136 + q * 16) = w; }
    if (tid < 128) ((LAS float*)(lds + M_NOFF))[tid] = R.nv + eL * ((LAS float*)(lds + M_GNOFF))[tid];
}
__device__ __forceinline__ void mlstm_group_state(const Params& P, int bh, int grp, LAS unsigned char* lds) {
    const int tid = threadIdx.x; unsigned char* ws = P.ws; const float* SR = (const float*)(ws + WS_SR); const float* SMC = (const float*)(ws + WS_SMC);
    LAS float* Dl = (LAS float*)(lds + M_GNOFF + 512);
#pragma unroll 1
    for (int g = 0; g < 7; ++g) { float ld = 0.f; if (g < grp) {
#pragma unroll
            for (int q = 0; q < 8; ++q) ld += SMC[bh * 64 + 8 * g + q] - SR[bh * SEQ + (8 * g + q) * 64 + 63]; }
        if (tid == 0) Dl[g] = __expf(ld); }
    __syncthreads();
    const bf16* ST = (const bf16*)(ws + WS_BUFB) + (size_t)bh * 64 * 16384;
#pragma unroll 1
    for (int i = 0; i < 4; ++i) { const int ch = tid + 512 * i;
        float a[8] = {0.f, 0.f, 0.f, 0.f, 0.f, 0.f, 0.f, 0.f};
#pragma unroll 1
        for (int g0 = 0; g0 < 8; g0 += 4) { u32x4 u[4];
#pragma unroll
            for (int j = 0; j < 4; ++j) { u[j] = (u32x4){0u, 0u, 0u, 0u}; if (g0 + j < grp) u[j] = *(const u32x4*)(ST + (size_t)(8 * (g0 + j) + 7) * 16384 + ch * 8); }
#pragma unroll
            for (int j = 0; j < 4; ++j) if (g0 + j < grp) { const float d = Dl[g0 + j];
                a[0] = d * a[0] + bflo(u[j].x); a[1] = d * a[1] + bfhi(u[j].x); a[2] = d * a[2] + bflo(u[j].y); a[3] = d * a[3] + bfhi(u[j].y);
                a[4] = d * a[4] + bflo(u[j].z); a[5] = d * a[5] + bfhi(u[j].z); a[6] = d * a[6] + bflo(u[j].w); a[7] = d * a[7] + bfhi(u[j].w); } }
        u32x4 w; w.x = pk2(a[0], a[1]); w.y = pk2(a[2], a[3]); w.z = pk2(a[4], a[5]); w.w = pk2(a[6], a[7]);
        *(LAS u32x4*)(lds + M_GOFF + ch * 16) = w; }
    if (tid < 128) { const float* ns = (const float*)(ws + WS_NS) + (size_t)bh * 64 * 128 + tid; float un[7], sn = 0.f;
#pragma unroll
        for (int g = 0; g < 7; ++g) un[g] = (g < grp) ? ns[(8 * g + 7) * 128] : 0.f;
#pragma unroll
        for (int g = 0; g < 7; ++g) if (g < grp) sn = Dl[g] * sn + un[g];
        ((LAS float*)(lds + M_GNOFF))[tid] = sn; }
}
__device__ __forceinline__ void mlstm_out_item(const Params& P, int item, int next, MBig& R, LAS unsigned char* lds) {
    const int tid = threadIdx.x, lane = tid & 63, wave = tid >> 6, fr = lane & 15, g = lane >> 4;
    const int bh = item >> 6, c = item & 63, b = bh >> 2, h = bh & 3, t0 = c * 64;
    unsigned char* ws = P.ws; const bf16* proj = (const bf16*)(ws + WS_MP);
    const float* SA = (const float*)(ws + WS_SA); const float* SR = (const float*)(ws + WS_SR); const float* SB = (const float*)(ws + WS_SB); const float* SMC = (const float*)(ws + WS_SMC);
    if ((c & 7) == 0) mlstm_group_state(P, bh, c >> 3, lds);
    const int tt = wave & 3, eh = wave >> 2, tq = tt * 16 + fr;
    const float r_t = SR[bh * SEQ + t0 + tq], b_t = SB[bh * SEQ + t0 + tq], mc = SMC[bh * 64 + c];
    f32x4 avs[4]; u32x2 mos[4]; f32x4 gns[4];
#pragma unroll
    for (int st = 0; st < 4; ++st) avs[st] = *(const f32x4*)(SA + bh * SEQ + t0 + st * 16 + 4 * g);
#pragma unroll
    for (int et = 0; et < 4; ++et) { const int e = eh * 64 + et * 16 + 4 * g; mos[et] = *(const u32x2*)(proj + mp_off(3, b, h, t0 + tq) + e); gns[et] = *(const f32x4*)(P.in[7] + h * 128 + e); }
    mlstm_out_stage(R, lds);
    __syncthreads();
    if (next >= 0) mlstm_out_load(P, next, R);
    bf16x8 qf[4];
#pragma unroll
    for (int ks = 0; ks < 4; ++ks) qf[ks] = *(const LAS bf16x8*)(lds + M_QOFF + tq * T136 + ks * 64 + g * 16);
    float pv[4][4]; float rsum = 0.f;
#pragma unroll
    for (int st = 0; st < 4; ++st) {
        if (st <= tt) { f32x4 a = (f32x4){0.f, 0.f, 0.f, 0.f};
#pragma unroll
            for (int ks = 0; ks < 4; ++ks) { const bf16x8 kf = *(const LAS bf16x8*)(lds + M_KOFF + (st * 16 + fr) * T136 + ks * 64 + g * 16); a = MFMA16(kf, qf[ks], a); }
            const f32x4 av = avs[st];
#pragma unroll
            for (int i = 0; i < 4; ++i) { const int s = st * 16 + 4 * g + i; const float p = (s <= tq) ? a[i] * __expf(av[i] - r_t) : 0.f; pv[st][i] = p; rsum += p; }
        } else {
#pragma unroll
            for (int i = 0; i < 4; ++i) pv[st][i] = 0.f; }
    }
    rsum += __shfl_xor(rsum, 16); rsum += __shfl_xor(rsum, 32);
    float qn = 0.f;
#pragma unroll
    for (int q = 0; q < 4; ++q) { const u32x4 w = *(const LAS u32x4*)(lds + M_QOFF + tq * T136 + g * 64 + q * 16);
        const f32x4 n0 = *(const LAS f32x4*)(lds + M_NOFF + (g * 32 + q * 8) * 4), n1 = *(const LAS f32x4*)(lds + M_NOFF + (g * 32 + q * 8 + 4) * 4);
        qn += (bflo(w.x) * n0[0] + bfhi(w.x) * n0[1]) + (bflo(w.y) * n0[2] + bfhi(w.y) * n0[3]) + (bflo(w.z) * n1[0] + bfhi(w.z) * n1[1]) + (bflo(w.w) * n1[2] + bfhi(w.w) * n1[3]); }
    qn += __shfl_xor(qn, 16); qn += __shfl_xor(qn, 32);
    const float w_inter = __expf(mc - r_t);
    const float den = w_inter * qn + rsum;
    const float idn = 1.0f / fmaxf(fabsf(den), __expf(-(b_t + r_t)));
    bf16x8 pf[2];
#pragma unroll
    for (int ks = 0; ks < 2; ++ks) { u32x4 w; w.x = pk2(pv[2 * ks][0], pv[2 * ks][1]); w.y = pk2(pv[2 * ks][2], pv[2 * ks][3]); w.z = pk2(pv[2 * ks + 1][0], pv[2 * ks + 1][1]); w.w = pk2(pv[2 * ks + 1][2], pv[2 * ks + 1][3]);
        pf[ks] = __builtin_bit_cast(bf16x8, w); }
    float hv[4][4]; float ssq = 0.f;
#pragma unroll
    for (int et = 0; et < 4; ++et) { const int e0 = eh * 64 + et * 16;
        f32x4 ag = (f32x4){0.f, 0.f, 0.f, 0.f}, ap = ag;
#pragma unroll
        for (int ks = 0; ks < 4; ++ks) { const bf16x8 cf = *(const LAS bf16x8*)(lds + M_COFF + (e0 + fr) * T136 + ks * 64 + g * 16); ag = MFMA16(cf, qf[ks], ag); }
#pragma unroll
        for (int ks = 0; ks < 2; ++ks) { const LAS unsigned char* vp = lds + M_VOFF + (e0 + fr) * T72 + (32 * ks + 4 * g) * 2;
            const u32x2 v0 = *(const LAS u32x2*)vp, v1 = *(const LAS u32x2*)(vp + 32); const u32x4 vw = (u32x4){v0.x, v0.y, v1.x, v1.y};
            ap = MFMA16(__builtin_bit_cast(bf16x8, vw), pf[ks], ap); }
#pragma unroll
        for (int i = 0; i < 4; ++i) { const float hh = (w_inter * ag[i] + ap[i]) * idn; hv[et][i] = hh; ssq += hh * hh; } }
    ssq += __shfl_xor(ssq, 16); ssq += __shfl_xor(ssq, 32);
    if (g == 0) ((LAS float*)(lds + M_SOFF))[tq * 2 + eh] = ssq;
    __syncthreads();
    const float tot = ((LAS float*)(lds + M_SOFF))[tq * 2] + ((LAS float*)(lds + M_SOFF))[tq * 2 + 1];
    const float rn = 1.0f / sqrtf(tot * (1.0f / 128.0f) + 1e-6f);
    const size_t tok = (size_t)b * SEQ + t0 + tq;
    bf16* mix = (bf16*)(ws + WS_MIX) + tok * DM + 512 + h * 128;
#pragma unroll
    for (int et = 0; et < 4; ++et) { const int e = eh * 64 + et * 16 + 4 * g;
        const u32x2 mo = mos[et]; const f32x4 gv = gns[et];
        const float m0 = bflo(mo.x), m1 = bfhi(mo.x), m2 = bflo(mo.y), m3 = bfhi(mo.y);
        const float y0 = hv[et][0] * rn * gv[0] * __builtin_amdgcn_rcpf(1.0f + __expf(-m0)), y1 = hv[et][1] * rn * gv[1] * __builtin_amdgcn_rcpf(1.0f + __expf(-m1));
        const float y2 = hv[et][2] * rn * gv[2] * __builtin_amdgcn_rcpf(1.0f + __expf(-m2)), y3 = hv[et][3] * rn * gv[3] * __builtin_amdgcn_rcpf(1.0f + __expf(-m3));
        u32x2 w; w.x = pk2(y0, y1); w.y = pk2(y2, y3); *(u32x2*)(mix + e) = w; }
    __syncthreads();
}

__device__ __forceinline__ void stage_conv_w(const Params& P, int h, bool kpart, LAS float* wl) {
    const int tid = threadIdx.x; const float* cw = P.in[4]; const float* cb = P.in[5]; const int ch0 = (kpart ? 512 : 0) + h * 128;
    for (int i = tid; i < 640; i += 512) { const int j = i >> 7, ch = i & 127; wl[i] = (j < 4) ? cw[j * 1024 + ch0 + ch] : cb[ch0 + ch]; }
}
__device__ __forceinline__ void conv_silu4_lds(const u32x4 (&xr)[7], const LAS float* wl, int ch, float scale, float (&o)[4][8]) {
    float wv[5][8];
#pragma unroll
    for (int j = 0; j < 5; ++j) { const f32x4 a = *(const LAS f32x4*)(wl + j * 128 + ch), c = *(const LAS f32x4*)(wl + j * 128 + ch + 4);
        wv[j][0] = a[0]; wv[j][1] = a[1]; wv[j][2] = a[2]; wv[j][3] = a[3]; wv[j][4] = c[0]; wv[j][5] = c[1]; wv[j][6] = c[2]; wv[j][7] = c[3]; }
    float xv[7][8];
#pragma unroll
    for (int i = 0; i < 7; ++i) { xv[i][0] = bflo(xr[i].x); xv[i][1] = bfhi(xr[i].x); xv[i][2] = bflo(xr[i].y); xv[i][3] = bfhi(xr[i].y); xv[i][4] = bflo(xr[i].z); xv[i][5] = bfhi(xr[i].z); xv[i][6] = bflo(xr[i].w); xv[i][7] = bfhi(xr[i].w); }
#pragma unroll
    for (int t = 0; t < 4; ++t)
#pragma unroll
        for (int e = 0; e < 8; ++e) { float a = wv[4][e];
#pragma unroll
            for (int j = 0; j < 4; ++j) a += wv[j][e] * xv[t + j][e];
            o[t][e] = a * __builtin_amdgcn_rcpf(1.0f + __expf(-a)) * scale; }
}
constexpr int F_KWOFF = 90112, F_DOFF = F_KWOFF + 128 * T72, F_WOFF = F_DOFF + 64;
struct FBig { u32x4 xr[7], va, vb; };
__device__ __forceinline__ void fused_load(const Params& P, int item, bool with_q, FBig& R) {
    const int tid = threadIdx.x; const int bh = item >> 6, c = item & 63, b = bh >> 2, h = bh & 3, t0 = c * 64; const bf16* proj = (const bf16*)(P.ws + WS_MP);
    if (tid < 256) { if (with_q) { const int cgp = tid & 15, tg = tid >> 4; load7(proj, 0, b, h, t0 + 4 * tg, cgp * 8, R.xr); } }
    else { const int idx = tid - 256, tg = idx & 15, cgp = idx >> 4; load7(proj, 1, b, h, t0 + 4 * tg, cgp * 8, R.xr); }
    { const int eg = tid >> 5, tg = tid & 31; const bf16* s0 = proj + mp_off(2, b, h, t0 + 2 * tg) + eg * 8; R.va = *(const u32x4*)s0; R.vb = *(const u32x4*)(s0 + 128); }
}
__device__ __forceinline__ void stage_vt_regs(const u32x4 va, const u32x4 vb, LAS unsigned char* vt) {
    const int tid = threadIdx.x, eg = tid >> 5, tg = tid & 31; LAS unsigned char* d = vt + (eg * 8) * T72 + tg * 4;
    *(LAS unsigned*)(d + 0 * T72) = (va.x & 0xffffu) | (vb.x << 16); *(LAS unsigned*)(d + 1 * T72) = (va.x >> 16) | (vb.x & 0xffff0000u);
    *(LAS unsigned*)(d + 2 * T72) = (va.y & 0xffffu) | (vb.y << 16); *(LAS unsigned*)(d + 3 * T72) = (va.y >> 16) | (vb.y & 0xffff0000u);
    *(LAS unsigned*)(d + 4 * T72) = (va.z & 0xffffu) | (vb.z << 16); *(LAS unsigned*)(d + 5 * T72) = (va.z >> 16) | (vb.z & 0xffff0000u);
    *(LAS unsigned*)(d + 6 * T72) = (va.w & 0xffffu) | (vb.w << 16); *(LAS unsigned*)(d + 7 * T72) = (va.w >> 16) | (vb.w & 0xffff0000u);
}
__device__ __forceinline__ void k_conv_stage(const Params& P, const FBig& R, int bh, int h, int t0, const LAS float* wk, LAS unsigned char* kwt, LAS unsigned char* knat) {
    const int idx = threadIdx.x - 256, tg = idx & 15, cgp = idx >> 4; const float* SA = (const float*)(P.ws + WS_SA); const float* SR = (const float*)(P.ws + WS_SR);
    const f32x4 av = *(const f32x4*)(SA + bh * SEQ + t0 + 4 * tg); const float rl = SR[bh * SEQ + t0 + 63];
    float o[4][8]; conv_silu4_lds(R.xr, wk, cgp * 8, 0.08838834764831845f, o);
    if (knat) {
#pragma unroll
        for (int t = 0; t < 4; ++t) { u32x4 w; w.x = pk2(o[t][0], o[t][1]); w.y = pk2(o[t][2], o[t][3]); w.z = pk2(o[t][4], o[t][5]); w.w = pk2(o[t][6], o[t][7]); *(LAS u32x4*)(knat + (4 * tg + t) * T136 + cgp * 16) = w; } }
    const float w0 = __expf(av[0] - rl), w1 = __expf(av[1] - rl), w2 = __expf(av[2] - rl), w3 = __expf(av[3] - rl);
    LAS unsigned char* d = kwt + (cgp * 8) * T72 + tg * 8;
#pragma unroll
    for (int e = 0; e < 8; ++e) { u32x2 w; w.x = pk2(o[0][e] * w0, o[1][e] * w1); w.y = pk2(o[2][e] * w2, o[3][e] * w3); *(LAS u32x2*)(d + e * T72) = w; }
}
__device__ __forceinline__ void mlstm_state_item(const Params& P, int item, int next, bool first, bool last, float& nrun, FBig& R, LAS unsigned char* lds) {
    const int tid = threadIdx.x, lane = tid & 63, wave = tid >> 6, fr = lane & 15, g = lane >> 4;
    const int bh = item >> 6, c = item & 63, h = bh & 3, t0 = c * 64; unsigned char* ws = P.ws; const float* SR = (const float*)(ws + WS_SR);
    LAS unsigned char* kwt = lds; LAS unsigned char* vt = lds + 128 * T72; LAS float* wk = (LAS float*)(lds + 106496);
    if (first) { stage_conv_w(P, h, true, wk); __syncthreads(); }
    if (tid >= 256) k_conv_stage(P, R, bh, h, t0, wk, kwt, nullptr);
    stage_vt_regs(R.va, R.vb, vt);
    __syncthreads();
    if (next >= 0) fused_load(P, next, false, R);
    const float dcy = first ? 0.f : __expf(((const float*)(ws + WS_SMC))[bh * 64 + c] - SR[bh * SEQ + t0 + 63]);
    if (tid < 128) { float s = 0.f;
#pragma unroll
        for (int q = 0; q < 8; ++q) { const u32x4 w = *(const LAS u32x4*)(kwt + tid * T72 + q * 16); s += (bflo(w.x) + bfhi(w.x)) + (bflo(w.y) + bfhi(w.y)) + (bflo(w.z) + bfhi(w.z)) + (bflo(w.w) + bfhi(w.w)); }
        nrun = dcy * nrun + s;
        if (last) ((float*)(ws + WS_NS))[(size_t)item * 128 + tid] = nrun; }
    bf16x8 vf[2];
#pragma unroll
    for (int ks = 0; ks < 2; ++ks) vf[ks] = *(const LAS bf16x8*)(vt + (wave * 16 + fr) * T72 + ks * 64 + g * 16);
    bf16* ST = (bf16*)(ws + WS_BUFB) + (size_t)item * 16384 + (wave * 16 + fr) * 128;
#pragma unroll
    for (int dt = 0; dt < 8; ++dt) { LAS f32x4* sp = (LAS f32x4*)(lds + 40960 + ((wave * 8 + dt) * 64 + lane) * 16);
        f32x4 a = (f32x4){0.f, 0.f, 0.f, 0.f}; if (!first) a = *sp * dcy;
#pragma unroll
        for (int ks = 0; ks < 2; ++ks) { const bf16x8 kf = *(const LAS bf16x8*)(kwt + (dt * 16 + fr) * T72 + ks * 64 + g * 16); a = MFMA16(kf, vf[ks], a); }
        *sp = a;
        if (last) { u32x2 w; w.x = pk2(a[0], a[1]); w.y = pk2(a[2], a[3]); *(u32x2*)(ST + dt * 16 + 4 * g) = w; } }
    __syncthreads();
}
__device__ __forceinline__ void fused_group_start(const Params& P, int bh, int grp, float& nrun, LAS unsigned char* lds) {
    f32x4 st[8];
    const int tid = threadIdx.x, lane = tid & 63, wave = tid >> 6, fr = lane & 15, g = lane >> 4; unsigned char* ws = P.ws;
    const float* SR = (const float*)(ws + WS_SR); const float* SMC = (const float*)(ws + WS_SMC);
    LAS float* Dl = (LAS float*)(lds + F_DOFF);
    stage_conv_w(P, bh & 3, false, (LAS float*)(lds + F_WOFF)); stage_conv_w(P, bh & 3, true, (LAS float*)(lds + F_WOFF) + 640);
#pragma unroll 1
    for (int gg = 0; gg < 7; ++gg) { float ld = 0.f; if (gg < grp) {
#pragma unroll
            for (int q = 0; q < 8; ++q) ld += SMC[bh * 64 + 8 * gg + q] - SR[bh * SEQ + (8 * gg + q) * 64 + 63]; }
        if (tid == 0) Dl[gg] = __expf(ld); }
    __syncthreads();
    const bf16* ST = (const bf16*)(ws + WS_BUFB) + (size_t)bh * 64 * 16384 + (wave * 16 + fr) * 128 + 4 * g;
#pragma unroll
    for (int dt = 0; dt < 8; ++dt) st[dt] = (f32x4){0.f, 0.f, 0.f, 0.f};
#pragma unroll 1
    for (int gg = 0; gg < grp; ++gg) { const float d = Dl[gg]; u32x2 u[8];
#pragma unroll
        for (int dt = 0; dt < 8; ++dt) u[dt] = *(const u32x2*)(ST + (size_t)(8 * gg + 7) * 16384 + dt * 16);
#pragma unroll
        for (int dt = 0; dt < 8; ++dt) { st[dt][0] = d * st[dt][0] + bflo(u[dt].x); st[dt][1] = d * st[dt][1] + bfhi(u[dt].x); st[dt][2] = d * st[dt][2] + bflo(u[dt].y); st[dt][3] = d * st[dt][3] + bfhi(u[dt].y); } }
#pragma unroll
    for (int dt = 0; dt < 8; ++dt) { u32x2 w; w.x = pk2(st[dt][0], st[dt][1]); w.y = pk2(st[dt][2], st[dt][3]); *(LAS u32x2*)(lds + M_COFF + (wave * 16 + fr) * T136 + (dt * 16 + 4 * g) * 2) = w; }
    if (tid < 128) { const float* ns = (const float*)(ws + WS_NS) + (size_t)bh * 64 * 128 + tid; float sn = 0.f;
#pragma unroll 1
        for (int gg = 0; gg < grp; ++gg) sn = Dl[gg] * sn + ns[(8 * gg + 7) * 128];
        nrun = sn; ((LAS float*)(lds + M_NOFF))[tid] = sn; }
}
__device__ __forceinline__ void mlstm_fused_item(const Params& P, int item, int next, float& nrun, FBig& R, LAS unsigned char* lds) {
    const int tid = threadIdx.x, lane = tid & 63, wave = tid >> 6, fr = lane & 15, g = lane >> 4;
    const int bh = item >> 6, c = item & 63, b = bh >> 2, h = bh & 3, t0 = c * 64;
    unsigned char* ws = P.ws; const bf16* proj = (const bf16*)(ws + WS_MP);
    const float* SA = (const float*)(ws + WS_SA); const float* SR = (const float*)(ws + WS_SR); const float* SB = (const float*)(ws + WS_SB); const float* SMC = (const float*)(ws + WS_SMC);
    if ((c & 7) == 0) fused_group_start(P, bh, c >> 3, nrun, lds);
    const int tt = wave & 3, eh = wave >> 2, tq = tt * 16 + fr;
    const float r_t = SR[bh * SEQ + t0 + tq], b_t = SB[bh * SEQ + t0 + tq], mc = SMC[bh * 64 + c];
    f32x4 avs[4];
#pragma unroll
    for (int st = 0; st < 4; ++st) avs[st] = *(const f32x4*)(SA + bh * SEQ + t0 + st * 16 + 4 * g);
    if (tid < 256) { const int cgp = tid & 15, tg = tid >> 4; float o[4][8]; conv_silu4_lds(R.xr, (const LAS float*)(lds + F_WOFF), cgp * 8, 1.0f, o);
#pragma unroll
        for (int t = 0; t < 4; ++t) { u32x4 w; w.x = pk2(o[t][0], o[t][1]); w.y = pk2(o[t][2], o[t][3]); w.z = pk2(o[t][4], o[t][5]); w.w = pk2(o[t][6], o[t][7]); *(LAS u32x4*)(lds + M_QOFF + (4 * tg + t) * T136 + cgp * 16) = w; } }
    else k_conv_stage(P, R, bh, h, t0, (const LAS float*)(lds + F_WOFF) + 640, lds + F_KWOFF, lds + M_KOFF);
    stage_vt_regs(R.va, R.vb, lds + M_VOFF);
    __syncthreads();
    if (next >= 0) fused_load(P, next, true, R);
    bf16x8 qf[4];
#pragma unroll
    for (int ks = 0; ks < 4; ++ks) qf[ks] = *(const LAS bf16x8*)(lds + M_QOFF + tq * T136 + ks * 64 + g * 16);
    float pv[4][4]; float rsum = 0.f;
#pragma unroll
    for (int st = 0; st < 4; ++st) {
        if (st <= tt) { f32x4 a = (f32x4){0.f, 0.f, 0.f, 0.f};
#pragma unroll
            for (int ks = 0; ks < 4; ++ks) { const bf16x8 kf = *(const LAS bf16x8*)(lds + M_KOFF + (st * 16 + fr) * T136 + ks * 64 + g * 16); a = MFMA16(kf, qf[ks], a); }
            const f32x4 av = avs[st];
#pragma unroll
            for (int i = 0; i < 4; ++i) { const int s = st * 16 + 4 * g + i; const float p = (s <= tq) ? a[i] * __expf(av[i] - r_t) : 0.f; pv[st][i] = p; rsum += p; }
        } else {
#pragma unroll
            for (int i = 0; i < 4; ++i) pv[st][i] = 0.f; }
    }
    rsum += __shfl_xor(rsum, 16); rsum += __shfl_xor(rsum, 32);
    float qn = 0.f;
#pragma unroll
    for (int q = 0; q < 4; ++q) { const u32x4 w = *(const LAS u32x4*)(lds + M_QOFF + tq * T136 + g * 64 + q * 16);
        const f32x4 n0 = *(const LAS f32x4*)(lds + M_NOFF + (g * 32 + q * 8) * 4), n1 = *(const LAS f32x4*)(lds + M_NOFF + (g * 32 + q * 8 + 4) * 4);
        qn += (bflo(w.x) * n0[0] + bfhi(w.x) * n0[1]) + (bflo(w.y) * n0[2] + bfhi(w.y) * n0[3]) + (bflo(w.z) * n1[0] + bfhi(w.z) * n1[1]) + (bflo(w.w) * n1[2] + bfhi(w.w) * n1[3]); }
    qn += __shfl_xor(qn, 16); qn += __shfl_xor(qn, 32);
    const float w_inter = __expf(mc - r_t);
    const float den = w_inter * qn + rsum;
    const float idn = 1.0f / fmaxf(fabsf(den), __expf(-(b_t + r_t)));
    bf16x8 pf[2];
#pragma unroll
    for (int ks = 0; ks < 2; ++ks) { u32x4 w; w.x = pk2(pv[2 * ks][0], pv[2 * ks][1]); w.y = pk2(pv[2 * ks][2], pv[2 * ks][3]); w.z = pk2(pv[2 * ks + 1][0], pv[2 * ks + 1][1]); w.w = pk2(pv[2 * ks + 1][2], pv[2 * ks + 1][3]);
        pf[ks] = __builtin_bit_cast(bf16x8, w); }
    u32x2 mos[4]; f32x4 gns[4];
#pragma unroll
    for (int et = 0; et < 4; ++et) { const int e = eh * 64 + et * 16 + 4 * g; mos[et] = *(const u32x2*)(proj + mp_off(3, b, h, t0 + tq) + e); gns[et] = *(const f32x4*)(P.in[7] + h * 128 + e); }
    float hv[4][4]; float ssq = 0.f;
#pragma unroll
    for (int et = 0; et < 4; ++et) { const int e0 = eh * 64 + et * 16;
        f32x4 ag = (f32x4){0.f, 0.f, 0.f, 0.f}, ap = ag;
#pragma unroll
        for (int ks = 0; ks < 4; ++ks) { const bf16x8 cf = *(const LAS bf16x8*)(lds + M_COFF + (e0 + fr) * T136 + ks * 64 + g * 16); ag = MFMA16(cf, qf[ks], ag); }
#pragma unroll
        for (int ks = 0; ks < 2; ++ks) { const LAS unsigned char* vp = lds + M_VOFF + (e0 + fr) * T72 + (32 * ks + 4 * g) * 2;
            const u32x2 v0 = *(const LAS u32x2*)vp, v1 = *(const LAS u32x2*)(vp + 32); const u32x4 vw = (u32x4){v0.x, v0.y, v1.x, v1.y};
            ap = MFMA16(__builtin_bit_cast(bf16x8, vw), pf[ks], ap); }
#pragma unroll
        for (int i = 0; i < 4; ++i) { const float hh = (w_inter * ag[i] + ap[i]) * idn; hv[et][i] = hh; ssq += hh * hh; } }
    ssq += __shfl_xor(ssq, 16); ssq += __shfl_xor(ssq, 32);
    if (g == 0) ((LAS float*)(lds + M_SOFF))[tq * 2 + eh] = ssq;
    __syncthreads();
    const float tot = ((LAS float*)(lds + M_SOFF))[tq * 2] + ((LAS float*)(lds + M_SOFF))[tq * 2 + 1];
    const float rn = 1.0f / sqrtf(tot * (1.0f / 128.0f) + 1e-6f);
    const size_t tok = (size_t)b * SEQ + t0 + tq;
    bf16* mix = (bf16*)(ws + WS_MIX) + tok * DM + 512 + h * 128;
#pragma unroll
    for (int et = 0; et < 4; ++et) { const int e = eh * 64 + et * 16 + 4 * g;
        const u32x2 mo = mos[et]; const f32x4 gv = gns[et];
        const float m0 = bflo(mo.x), m1 = bfhi(mo.x), m2 = bflo(mo.y), m3 = bfhi(mo.y);
        const float y0 = hv[et][0] * rn * gv[0] * __builtin_amdgcn_rcpf(1.0f + __expf(-m0)), y1 = hv[et][1] * rn * gv[1] * __builtin_amdgcn_rcpf(1.0f + __expf(-m1));
        const float y2 = hv[et][2] * rn * gv[2] * __builtin_amdgcn_rcpf(1.0f + __expf(-m2)), y3 = hv[et][3] * rn * gv[3] * __builtin_amdgcn_rcpf(1.0f + __expf(-m3));
        u32x2 w; w.x = pk2(y0, y1); w.y = pk2(y2, y3); *(u32x2*)(mix + e) = w; }
    { const float dcy = __expf(mc - SR[bh * SEQ + t0 + 63]);
      LAS unsigned char* kwt = lds + F_KWOFF; LAS unsigned char* vt = lds + M_VOFF;
      if (tid < 128) { float s = 0.f;
#pragma unroll
          for (int q = 0; q < 8; ++q) { const u32x4 w = *(const LAS u32x4*)(kwt + tid * T72 + q * 16); s += (bflo(w.x) + bfhi(w.x)) + (bflo(w.y) + bfhi(w.y)) + (bflo(w.z) + bfhi(w.z)) + (bflo(w.w) + bfhi(w.w)); }
          nrun = dcy * nrun + s; ((LAS float*)(lds + M_NOFF))[tid] = nrun; }
      bf16x8 vf[2];
#pragma unroll
      for (int ks = 0; ks < 2; ++ks) vf[ks] = *(const LAS bf16x8*)(vt + (wave * 16 + fr) * T72 + ks * 64 + g * 16);
#pragma unroll
      for (int dt = 0; dt < 8; ++dt) { LAS u32x2* cp = (LAS u32x2*)(lds + M_COFF + (wave * 16 + fr) * T136 + (dt * 16 + 4 * g) * 2);
          const u32x2 cw = *cp; f32x4 a = (f32x4){bflo(cw.x), bfhi(cw.x), bflo(cw.y), bfhi(cw.y)} * dcy;
#pragma unroll
          for (int ks = 0; ks < 2; ++ks) { const bf16x8 kf = *(const LAS bf16x8*)(kwt + (dt * 16 + fr) * T72 + ks * 64 + g * 16); a = MFMA16(kf, vf[ks], a); }
          u32x2 w; w.x = pk2(a[0], a[1]); w.y = pk2(a[2], a[3]); *cp = w; } }
    __syncthreads();
}

__device__ __forceinline__ void attn_combine(const Params& P) {
    unsigned char* ws = P.ws; const bf16* OP = (const bf16*)(ws + WS_OP); const float* LSE = (const float*)(ws + WS_LSE); bf16* mix = (bf16*)(ws + WS_MIX);
    const int G = gridDim.x;
    for (int idx0 = blockIdx.x * 512 + threadIdx.x; idx0 < MT * 64; idx0 += G * 512 * 4) {
        float l[4][3]; u32x4 v[4][3];
#pragma unroll
        for (int q = 0; q < 4; ++q) { const int idx = idx0 + q * G * 512; if (idx < MT * 64) { const int tok = idx >> 6, cc = idx & 63, h = cc >> 3;
#pragma unroll
            for (int p = 0; p < 3; ++p) { l[q][p] = LSE[(size_t)p * MT * 8 + (size_t)tok * 8 + h]; v[q][p] = *(const u32x4*)(OP + (size_t)p * MT * 512 + (size_t)tok * 512 + cc * 8); } } }
#pragma unroll
        for (int q = 0; q < 4; ++q) { const int idx = idx0 + q * G * 512; if (idx < MT * 64) { const int tok = idx >> 6, cc = idx & 63;
            const float mx = fmaxf(l[q][0], fmaxf(l[q][1], l[q][2])); float w0 = __expf(l[q][0] - mx), w1 = __expf(l[q][1] - mx), w2 = __expf(l[q][2] - mx); const float iw = __builtin_amdgcn_rcpf(w0 + w1 + w2); w0 *= iw; w1 *= iw; w2 *= iw;
            const u32x4 a = v[q][0], bq = v[q][1], cq = v[q][2]; u32x4 o;
            o.x = pk2(w0 * bflo(a.x) + w1 * bflo(bq.x) + w2 * bflo(cq.x), w0 * bfhi(a.x) + w1 * bfhi(bq.x) + w2 * bfhi(cq.x));
            o.y = pk2(w0 * bflo(a.y) + w1 * bflo(bq.y) + w2 * bflo(cq.y), w0 * bfhi(a.y) + w1 * bfhi(bq.y) + w2 * bfhi(cq.y));
            o.z = pk2(w0 * bflo(a.z) + w1 * bflo(bq.z) + w2 * bflo(cq.z), w0 * bfhi(a.z) + w1 * bfhi(bq.z) + w2 * bfhi(cq.z));
            o.w = pk2(w0 * bflo(a.w) + w1 * bflo(bq.w) + w2 * bflo(cq.w), w0 * bfhi(a.w) + w1 * bfhi(bq.w) + w2 * bfhi(cq.w));
            *(u32x4*)(mix + (size_t)tok * DM + cc * 8) = o; } }
    }
}

__device__ __forceinline__ void final_norm(const Params& P) {
    const int lane = threadIdx.x & 63, wave = threadIdx.x >> 6, G = gridDim.x; const float* SSQ = (const float*)(P.ws + WS_SSQ3); const float* gf = P.in[15];
    const bf16* H3 = (const bf16*)(P.ws + WS_BUFB);
    f32x4 gv[4];
#pragma unroll
    for (int j = 0; j < 2; ++j) { gv[2 * j] = *(const f32x4*)(gf + j * 512 + lane * 8); gv[2 * j + 1] = *(const f32x4*)(gf + j * 512 + lane * 8 + 4); }
    for (int row0 = (blockIdx.x * 8 + wave) * 4; row0 < MT; row0 += G * 32) {
        u32x4 v[4][2]; float rs[4];
#pragma unroll
        for (int r = 0; r < 4; ++r) { rs[r] = pg8::row_rs(SSQ, row0 + r);
#pragma unroll
            for (int j = 0; j < 2; ++j) v[r][j] = *(const u32x4*)(H3 + (size_t)(row0 + r) * DM + j * 512 + lane * 8); }
#pragma unroll
        for (int r = 0; r < 4; ++r) { float* o = P.out + (size_t)(row0 + r) * DM;
#pragma unroll
            for (int j = 0; j < 2; ++j) { const u32x4 w = v[r][j];
                *(f32x4*)(o + j * 512 + lane * 8) = (f32x4){bflo(w.x), bfhi(w.x), bflo(w.y), bfhi(w.y)} * rs[r] * gv[2 * j];
                *(f32x4*)(o + j * 512 + lane * 8 + 4) = (f32x4){bflo(w.z), bfhi(w.z), bflo(w.w), bfhi(w.w)} * rs[r] * gv[2 * j + 1]; } }
    }
}

__global__ void __launch_bounds__(512, 2) hymba_fwd(Params P) {
    extern __shared__ __attribute__((aligned(16))) unsigned char lds_raw[];
    LAS unsigned char* lds = (LAS unsigned char*)lds_raw;
    unsigned char* ws = P.ws; const int G = gridDim.x, bx = blockIdx.x;
    const int lo = P.ph_lo, hi = P.ph_hi;
#define IN(k) (lo <= (k) && (k) < hi)
    if (threadIdx.x < 2) ((volatile LAS unsigned*)(lds + LDS_BAR_OFF))[threadIdx.x] = 0u;
    __syncthreads();
    XcdBarrier bar; bar.bar = (unsigned*)(ws + WS_CTL); bar.x = 0; bar.st = nullptr;
    if (hi - lo > 1) bar = xcd_barrier_post((unsigned*)(ws + WS_CTL), (volatile LAS unsigned*)(lds + LDS_BAR_OFF));
    if (hi == 1000) cg::this_grid().sync();
#define SEAM(k) do { if (IN(k) && IN((k) + 1)) { xcd_barrier(bar); } } while (0)
    if (IN(0)) { p0_prologue(P, lds); }
#if REP_PHASE == 0
    __syncthreads(); p0_prologue(P, lds);
#endif
    SEAM(0);
    if (IN(1)) {
        if (bx < 32) gate_scan(P, bx, lds);
        pg8::Gemm gm{(const pg8::bf16_t*)(ws + WS_BUFA), (const pg8::bf16_t*)(ws + WS_WIN), MT, NPROJ, DM}; pg8::StaticOrder S; S.init(MT, NPROJ, G, bx);
        pg8::EpiProj E{(pg8::bf16_t*)(ws + WS_QKV), (pg8::bf16_t*)(ws + WS_MP), (const float*)(ws + WS_ROPE), (const float*)(ws + WS_ROPE) + 4096 * 8};
        pg8::gemm_phase_sp<pg8::EpiProj, pg8::StaticOrder, true, true>(lds, gm, S, E);
#if REP_PHASE == 1
        __syncthreads(); pg8::gemm_phase_sp<pg8::EpiProj, pg8::StaticOrder, true, true>(lds, gm, S, E);
#endif
    }
    SEAM(1);
    if (IN(2)) {
        { FBig R; float nrun = 0.f;
          if (bx < 256) fused_load(P, bx * 8, false, R);
          for (int gi = bx; gi < 256; gi += G)
              for (int i = 0; i < 8; ++i) { const int it = gi * 8 + i; const int nx = (i < 7) ? it + 1 : ((gi + G < 256) ? (gi + G) * 8 : -1);
                  mlstm_state_item(P, it, nx, i == 0, i == 7, nrun, R, lds); } }
        attn_phase(P, lds);
    #if REP_PHASE == 2
        __syncthreads();
        { FBig R; float nrun = 0.f;
          if (bx < 256) fused_load(P, bx * 8, false, R);
          for (int gi = bx; gi < 256; gi += G)
              for (int i = 0; i < 8; ++i) { const int it = gi * 8 + i; const int nx = (i < 7) ? it + 1 : ((gi + G < 256) ? (gi + G) * 8 : -1);
                  mlstm_state_item(P, it, nx, i == 0, i == 7, nrun, R, lds); } }
        attn_phase(P, lds);
    #endif
    }
    SEAM(2);
#if REP_PHASE == 3
    __syncthreads(); mlstm_scan(P);
#endif
    if (IN(4)) {
        { FBig R; float nrun = 0.f;
          if (bx < 256) fused_load(P, bx * 8, true, R);
          for (int gi = bx; gi < 256; gi += G)
              for (int i = 0; i < 8; ++i) { const int it = gi * 8 + i; const int nx = (i < 7) ? it + 1 : ((gi + G < 256) ? (gi + G) * 8 : -1);
                  mlstm_fused_item(P, it, nx, nrun, R, lds); } }
        attn_combine(P);
    #if REP_PHASE == 4
        __syncthreads();
        { FBig R; float nrun = 0.f;
          if (bx < 256) fused_load(P, bx * 8, true, R);
          for (int gi = bx; gi < 256; gi += G)
              for (int i = 0; i < 8; ++i) { const int it = gi * 8 + i; const int nx = (i < 7) ? it + 1 : ((gi + G < 256) ? (gi + G) * 8 : -1);
                  mlstm_fused_item(P, it, nx, nrun, R, lds); } }
        attn_combine(P);
    #endif
    }
    SEAM(4);
    if (IN(5)) {
        pg8::Gemm gm{(const pg8::bf16_t*)(ws + WS_MIX), (const pg8::bf16_t*)(ws + WS_WOUT), MT, DM, DM}; pg8::StaticOrder S; S.init(MT, DM, G, bx);
        pg8::EpiRes<false> E{P.in[0], (pg8::bf16_t*)(ws + WS_BUFB), (float*)(ws + WS_SSQ1)};
        pg8::gemm_phase_sp<pg8::EpiRes<false>, pg8::StaticOrder, false, true>(lds, gm, S, E);
#if REP_PHASE == 5
        __syncthreads(); pg8::gemm_phase_sp<pg8::EpiRes<false>, pg8::StaticOrder, false, true>(lds, gm, S, E);
#endif
    }
    SEAM(5);
    if (IN(6)) {
        pg8::Gemm gm{(const pg8::bf16_t*)(ws + WS_BUFB), (const pg8::bf16_t*)(ws + WS_WUP), MT, FF, DM}; pg8::StaticOrder S; S.init(MT, FF, G, bx);
        pg8::EpiUp E{(pg8::bf16_t*)(ws + WS_ACT), (const float*)(ws + WS_SSQ1)};
        pg8::gemm_phase_sp<pg8::EpiUp, pg8::StaticOrder, true, true>(lds, gm, S, E);
#if REP_PHASE == 6
        __syncthreads(); pg8::gemm_phase_sp<pg8::EpiUp, pg8::StaticOrder, true, true>(lds, gm, S, E);
#endif
    }
    SEAM(6);
    if (IN(7)) {
        pg8::Gemm gm{(const pg8::bf16_t*)(ws + WS_ACT), (const pg8::bf16_t*)(ws + WS_WDN), MT, DM, FF}; pg8::StaticOrder S; S.init(MT, DM, G, bx);
        pg8::EpiRes<true> E{ws + WS_BUFB, (pg8::bf16_t*)(ws + WS_BUFA), (float*)(ws + WS_SSQ2)};
        pg8::gemm_phase_sp<pg8::EpiRes<true>, pg8::StaticOrder, false, true>(lds, gm, S, E);
#if REP_PHASE == 7
        __syncthreads(); pg8::gemm_phase_sp<pg8::EpiRes<true>, pg8::StaticOrder, false, true>(lds, gm, S, E);
#endif
    }
    SEAM(7);
    if (IN(8)) {
        { pg8::Gemm gm{(const pg8::bf16_t*)(ws + WS_PB), (const pg8::bf16_t*)(ws + WS_WPLE), MT, DM, PLE}; pg8::StaticOrder S; S.init(MT, DM, G, bx);
          pg8::EpiStoreBf16 E{(pg8::bf16_t*)(ws + WS_BUFB), DM};
          pg8::gemm_phase<pg8::EpiStoreBf16, pg8::StaticOrder>(lds, gm, S, E, nullptr); }
        __syncthreads();
        { pg8::Gemm gm{(const pg8::bf16_t*)(ws + WS_BUFA), (const pg8::bf16_t*)(ws + WS_WPG), MT, DM, DM}; pg8::StaticOrder S; S.init(MT, DM, G, bx);
          pg8::EpiPle E{(const pg8::bf16_t*)(ws + WS_BUFA), (pg8::bf16_t*)(ws + WS_BUFB), (const float*)(ws + WS_SSQ2), (float*)(ws + WS_SSQ3)};
          pg8::gemm_phase_sp<pg8::EpiPle, pg8::StaticOrder, false, true>(lds, gm, S, E); }
#if REP_PHASE == 8
        __syncthreads();
        { pg8::Gemm gm{(const pg8::bf16_t*)(ws + WS_PB), (const pg8::bf16_t*)(ws + WS_WPLE), MT, DM, PLE}; pg8::StaticOrder S; S.init(MT, DM, G, bx);
          pg8::EpiStoreBf16 E{(pg8::bf16_t*)(ws + WS_BUFB), DM};
          pg8::gemm_phase<pg8::EpiStoreBf16, pg8::StaticOrder>(lds, gm, S, E, nullptr); }
        __syncthreads();
        { pg8::Gemm gm{(const pg8::bf16_t*)(ws + WS_BUFA), (const pg8::bf16_t*)(ws + WS_WPG), MT, DM, DM}; pg8::StaticOrder S; S.init(MT, DM, G, bx);
          pg8::EpiPle E{(const pg8::bf16_t*)(ws + WS_BUFA), (pg8::bf16_t*)(ws + WS_BUFB), (const float*)(ws + WS_SSQ2), (float*)(ws + WS_SSQ3)};
          pg8::gemm_phase_sp<pg8::EpiPle, pg8::StaticOrder, false, true>(lds, gm, S, E); }
#endif
    }
    SEAM(8);
    if (IN(9)) { final_norm(P); }
#if REP_PHASE == 9
    __syncthreads(); final_norm(P);
#endif
#undef IN
#undef SEAM
}

extern "C" void kernel_launch(void* const* d_in, const int* in_sizes, int n_in, void* d_out, int out_size, void* d_ws, size_t ws_size, hipStream_t stream) {
    static int grid = 0;
    if (grid == 0) {
        if (n_in != 16 || out_size != MT * DM || ws_size < WS_END) { fprintf(stderr, "kernel_launch: unexpected shapes (n_in %d out %d ws %zu)\n", n_in, out_size, ws_size); grid = -1; return; }
        int dev = 0, cus = 0, per_cu = 0;
        (void)hipGetDevice(&dev); (void)hipDeviceGetAttribute(&cus, hipDeviceAttributeMultiprocessorCount, dev);
        if (hipFuncSetAttribute((const void*)hymba_fwd, hipFuncAttributeMaxDynamicSharedMemorySize, LDS_BYTES) != hipSuccess) { fprintf(stderr, "kernel_launch: hipFuncSetAttribute failed\n"); grid = -1; return; }
        if (hipOccupancyMaxActiveBlocksPerMultiprocessor(&per_cu, (const void*)hymba_fwd, 512, LDS_BYTES) != hipSuccess || per_cu < 1) { fprintf(stderr, "kernel_launch: occupancy query gave %d\n", per_cu); per_cu = 1; }
        (void)hipGetLastError();
        grid = cus;
        fprintf(stderr, "kernel_launch: grid %d (occupancy %d per CU)\n", grid, per_cu);
    }
    if (grid < 0) return;
    (void)hipMemsetAsync((unsigned char*)d_ws + WS_CTL, 0, CTL_BYTES, stream);
    Params p{};
    for (int i = 0; i < 16; ++i) p.in[i] = (const float*)d_in[i];
    p.out = (float*)d_out; p.ws = (unsigned char*)d_ws;
#if MK_LAUNCHES == 1
    p.ph_lo = 0; p.ph_hi = 10;
    void* args[] = {&p};
    hipError_t e = hipLaunchCooperativeKernel((const void*)hymba_fwd, dim3(grid), dim3(512), args, LDS_BYTES, stream);
    if (e != hipSuccess) fprintf(stderr, "kernel_launch: cooperative launch failed: %s\n", hipGetErrorString(e));
#else
    for (int ph = 0; ph < 10; ++ph) { p.ph_lo = ph; p.ph_hi = ph + 1; hipLaunchKernelGGL(hymba_fwd, dim3(grid), dim3(512), LDS_BYTES, stream, p); }
#endif
}
```

```cpp
#include <hip/hip_runtime.h>
#include <hip/hip_cooperative_groups.h>
#include <cstdio>
#include <cstdint>
namespace cg = cooperative_groups;
#ifndef REP_PHASE
#define REP_PHASE -1
#endif
#ifndef MK_LAUNCHES
#define MK_LAUNCHES 1
#endif
namespace pg8 {
#define PG8_LAS __attribute__((address_space(3)))
typedef unsigned short bf16_t;
typedef short bf16x8 __attribute__((ext_vector_type(8)));
typedef float f32x4 __attribute__((ext_vector_type(4)));
typedef unsigned u32x4 __attribute__((ext_vector_type(4)));
constexpr int BM = 256, BK = 64, HALF = 128, HTB = HALF * BK * 2  , STAGE_BYTES = 8 * HTB, NXCD = 8, WGM = 8;

__host__ __device__ __forceinline__ int lds_byte(int r, int c) { const int st = (r >> 4) * 2 + (c >> 5), rr = r & 15, cc = c & 31, ob = rr * 64 + cc * 2; return st * 1024 + (ob ^ (((ob >> 9) & 1) << 5)); }
__host__ __device__ __forceinline__ void stage_rc(int b, int& R, int& C) { const int st = b / 1024, sb = b % 1024, swz = sb ^ (((sb >> 9) & 1) << 5); R = (st >> 1) * 16 + swz / 64; C = (st & 1) * 32 + (swz % 64) / 2; }
__host__ __device__ __forceinline__ int perm32(int rho) { const int n = rho >> 4, i = rho & 15; return 8 * (i >> 2) + 4 * n + (i & 3); }

struct Unit { int pm, pn; };
struct Gemm { const bf16_t* A; const bf16_t* Bt; int M, N, K; };

struct StaticOrder {
    int nM, nN, nwg, G, c;
    __host__ __device__ void init(int M, int N, int G_, int c_) { nM = M / BM; nN = N / BM; nwg = nM * nN; G = G_; c = c_; }
    __host__ __device__ bool next(int i, Unit& u) const {
        const long L = (long)i * G + c; if (L >= nwg) return false;
        int wgid = (int)L; { const int q = nwg / NXCD, r = nwg % NXCD, xcd = wgid % NXCD, off = wgid / NXCD; wgid = (xcd < r ? xcd * (q + 1) : r * (q + 1) + (xcd - r) * q) + off; }
        const int nig = WGM * nN, gid = wgid / nig, fm = gid * WGM, gsz = (nM - fm) < WGM ? (nM - fm) : WGM;
        u.pm = fm + ((wgid % nig) % gsz); u.pn = (wgid % nig) / gsz; return true;
    }
    __device__ __forceinline__ void a_ready(const Unit&) const {}
    __device__ __forceinline__ void done(const Unit&) const {}
};
typedef __bf16 bf16x2_t __attribute__((ext_vector_type(2)));
typedef float f32x2_t __attribute__((ext_vector_type(2)));
__device__ __forceinline__ unsigned cvt_pk_bf16(float lo, float hi) { const f32x2_t v = {lo, hi}; return __builtin_bit_cast(unsigned, __builtin_convertvector(v, bf16x2_t)); }
constexpr float RMS_EPS_F = 1e-6f;
__device__ __forceinline__ float bf_lo(unsigned w) { return __builtin_bit_cast(float, w << 16); }
__device__ __forceinline__ float bf_hi(unsigned w) { return __builtin_bit_cast(float, w & 0xffff0000u); }
__device__ __forceinline__ float row_rs(const float* ssq, int row) {
    const f32x4* sp = (const f32x4*)(ssq + (size_t)row * 16);
    const f32x4 t = (sp[0] + sp[1]) + (sp[2] + sp[3]);
    return __builtin_amdgcn_rsqf(((t[0] + t[1]) + (t[2] + t[3])) * (1.0f / 1024.0f) + RMS_EPS_F);
}
__device__ __forceinline__ float rs_from_quarter(const f32x4 t) {
    float s = (t[0] + t[1]) + (t[2] + t[3]); s += __shfl_xor(s, 16); s += __shfl_xor(s, 32);
    return __builtin_amdgcn_rsqf(s * (1.0f / 1024.0f) + RMS_EPS_F);
}
struct EpiStoreBf16 {
    static constexpr bool PERM = true, AFTER_DRAIN = false;
    bf16_t* O; int ldc;
    __device__ __forceinline__ void operator()(const f32x4 (&acc)[2][2][4][2], const Unit& u, int wr, int wc, int fr, int fq) const {
        const int row0 = u.pm * BM + wr * 64 + fr, col0 = u.pn * BM + wc * 32 + 8 * fq;
#pragma unroll
        for (int ai = 0; ai < 2; ++ai)
#pragma unroll
            for (int m = 0; m < 4; ++m) { bf16_t* rowp = O + (size_t)(row0 + ai * HALF + m * 16) * ldc + col0;
#pragma unroll
                for (int bj = 0; bj < 2; ++bj) { const f32x4 v0 = acc[ai][bj][m][0], v1 = acc[ai][bj][m][1];
                    u32x4 w; w.x = cvt_pk_bf16(v0[0], v0[1]); w.y = cvt_pk_bf16(v0[2], v0[3]); w.z = cvt_pk_bf16(v1[0], v1[1]); w.w = cvt_pk_bf16(v1[2], v1[3]);
                    *(u32x4*)(rowp + bj * HALF) = w; } }
    }
};
struct EpiProj {
    static constexpr bool PERM = true, AFTER_DRAIN = false;
    bf16_t* QKV; bf16_t* MP; const float* rc; const float* rsn;
    __device__ __forceinline__ void operator()(const f32x4 (&acc)[2][2][4][2], const Unit& u, int wr, int wc, int fr, int fq) const {
        const int row0 = u.pm * BM + wr * 64 + fr, col0 = u.pn * BM + wc * 32 + 8 * fq;
        const bool rope = (u.pn < 4) && ((wc & 1) == 0);
        size_t cofs[2];
#pragma unroll
        for (int bj = 0; bj < 2; ++bj) { const int col = col0 + bj * HALF;
            if (u.pn < 6) { const int sect = col >> 9, h = (col >> 6) & 7, d = col & 63; cofs[bj] = ((size_t)(sect * 64 + h) * 4096) * 64 + d; }
            else { const int c2 = col - 1536, sect = c2 >> 9, h = (c2 >> 7) & 3, d = c2 & 127; cofs[bj] = ((size_t)(sect * 32 + h) * 4096) * 128 + d; } }
        bf16_t* base = (u.pn < 6) ? QKV : MP; const int rsh = (u.pn < 6) ? 6 : 7; const size_t bstride = (u.pn < 6) ? (size_t)8 * 4096 * 64 : (size_t)4 * 4096 * 128;
#pragma unroll
        for (int ai = 0; ai < 2; ++ai)
#pragma unroll
            for (int m = 0; m < 4; ++m) { const int row = row0 + ai * HALF + m * 16; const int b = row >> 12, t = row & 4095; bf16_t* rowp = base + (size_t)b * bstride + ((size_t)t << rsh);
                f32x4 c0 = (f32x4){1.f, 1.f, 1.f, 1.f}, c1 = c0, s0 = (f32x4){0.f, 0.f, 0.f, 0.f}, s1 = s0;
                if (rope) { c0 = *(const f32x4*)(rc + t * 8); c1 = *(const f32x4*)(rc + t * 8 + 4); s0 = *(const f32x4*)(rsn + t * 8); s1 = *(const f32x4*)(rsn + t * 8 + 4);
                    if (fq == 0) { s0 = -s0; s1 = -s1; } if (fq >= 2) { c0 = (f32x4){1.f, 1.f, 1.f, 1.f}; c1 = c0; s0 = (f32x4){0.f, 0.f, 0.f, 0.f}; s1 = s0; } }
#pragma unroll
                for (int bj = 0; bj < 2; ++bj) { f32x4 v0 = acc[ai][bj][m][0], v1 = acc[ai][bj][m][1];
                    if (rope) { f32x4 p0, p1;
#pragma unroll
                        for (int j = 0; j < 4; ++j) { p0[j] = __shfl_xor(v0[j], 16); p1[j] = __shfl_xor(v1[j], 16); }
                        v0 = v0 * c0 + p0 * s0; v1 = v1 * c1 + p1 * s1; }
                    u32x4 w; w.x = cvt_pk_bf16(v0[0], v0[1]); w.y = cvt_pk_bf16(v0[2], v0[3]); w.z = cvt_pk_bf16(v1[0], v1[1]); w.w = cvt_pk_bf16(v1[2], v1[3]);
                    *(u32x4*)(rowp + cofs[bj]) = w; } }
    }
};
template <bool BASE_BF16> struct EpiRes {
    static constexpr bool PERM = true, AFTER_DRAIN = false;
    const void* base; bf16_t* HB; float* SSQ;
    __device__ __forceinline__ void operator()(const f32x4 (&acc)[2][2][4][2], const Unit& u, int wr, int wc, int fr, int fq) const {
        const int row0 = u.pm * BM + wr * 64 + fr, col0 = u.pn * BM + wc * 32 + 8 * fq;
        constexpr int NB = BASE_BF16 ? 1 : 2, AIB = BASE_BF16 ? 2 : 1;
#pragma unroll
        for (int bt = 0; bt < NB; ++bt) {
            f32x4 bb[AIB][4][2][BASE_BF16 ? 1 : 2];
#pragma unroll
            for (int a = 0; a < AIB; ++a)
#pragma unroll
                for (int m = 0; m < 4; ++m)
#pragma unroll
                    for (int bj = 0; bj < 2; ++bj) { const int ai = bt * AIB + a; const size_t o = (size_t)(row0 + ai * HALF + m * 16) * 1024 + col0 + bj * HALF;
                        if (BASE_BF16) { const u32x4 w = *(const u32x4*)((const bf16_t*)base + o); bb[a][m][bj][0] = __builtin_bit_cast(f32x4, w); }
                        else { bb[a][m][bj][0] = *(const f32x4*)((const float*)base + o); bb[a][m][bj][BASE_BF16 ? 0 : 1] = *(const f32x4*)((const float*)base + o + 4); } }
#pragma unroll
            for (int a = 0; a < AIB; ++a)
#pragma unroll
                for (int m = 0; m < 4; ++m) { const int ai = bt * AIB + a; const int row = row0 + ai * HALF + m * 16; const size_t ro = (size_t)row * 1024 + col0; float ss = 0.f;
#pragma unroll
                    for (int bj = 0; bj < 2; ++bj) {
                        f32x4 b0, b1;
                        if (BASE_BF16) { const u32x4 w = __builtin_bit_cast(u32x4, bb[a][m][bj][0]); b0 = (f32x4){bf_lo(w.x), bf_hi(w.x), bf_lo(w.y), bf_hi(w.y)}; b1 = (f32x4){bf_lo(w.z), bf_hi(w.z), bf_lo(w.w), bf_hi(w.w)}; }
                        else { b0 = bb[a][m][bj][0]; b1 = bb[a][m][bj][BASE_BF16 ? 0 : 1]; }
                        const f32x4 v0 = acc[ai][bj][m][0] + b0, v1 = acc[ai][bj][m][1] + b1;
                        u32x4 w; w.x = cvt_pk_bf16(v0[0], v0[1]); w.y = cvt_pk_bf16(v0[2], v0[3]); w.z = cvt_pk_bf16(v1[0], v1[1]); w.w = cvt_pk_bf16(v1[2], v1[3]);
                        *(u32x4*)(HB + ro + bj * HALF) = w;
                        ss += (v0[0] * v0[0] + v0[1] * v0[1]) + (v0[2] * v0[2] + v0[3] * v0[3]) + (v1[0] * v1[0] + v1[1] * v1[1]) + (v1[2] * v1[2] + v1[3] * v1[3]); }
                    ss += __shfl_xor(ss, 16); ss += __shfl_xor(ss, 32);
                    if (fq == 0) SSQ[(size_t)row * 16 + u.pn * 4 + wc] = ss; }
        }
    }
};
struct EpiUp {
    static constexpr bool PERM = true, AFTER_DRAIN = false;
    bf16_t* O; const float* SSQ;
    __device__ __forceinline__ void operator()(const f32x4 (&acc)[2][2][4][2], const Unit& u, int wr, int wc, int fr, int fq) const {
        const int row0 = u.pm * BM + wr * 64 + fr, col0 = u.pn * BM + wc * 32 + 8 * fq;
#pragma unroll
        for (int ai = 0; ai < 2; ++ai) {
            f32x4 qv[4];
#pragma unroll
            for (int m = 0; m < 4; ++m) qv[m] = *(const f32x4*)(SSQ + (size_t)(row0 + ai * HALF + m * 16) * 16 + 4 * fq);
#pragma unroll
            for (int m = 0; m < 4; ++m) { const int row = row0 + ai * HALF + m * 16; const float rs = rs_from_quarter(qv[m]); bf16_t* rowp = O + (size_t)row * 4096 + col0;
#pragma unroll
                for (int bj = 0; bj < 2; ++bj) { f32x4 v0 = acc[ai][bj][m][0] * rs, v1 = acc[ai][bj][m][1] * rs;
#pragma unroll
                    for (int j = 0; j < 4; ++j) { const float a = fmaxf(v0[j], 0.f), b = fmaxf(v1[j], 0.f); v0[j] = a * a; v1[j] = b * b; }
                    u32x4 w; w.x = cvt_pk_bf16(v0[0], v0[1]); w.y = cvt_pk_bf16(v0[2], v0[3]); w.z = cvt_pk_bf16(v1[0], v1[1]); w.w = cvt_pk_bf16(v1[2], v1[3]);
                    *(u32x4*)(rowp + bj * HALF) = w; } } }
    }
};
struct EpiPle {
    static constexpr bool PERM = true, AFTER_DRAIN = false;
    const bf16_t* H2; bf16_t* EH; const float* SSQ; float* SSQO;
    __device__ __forceinline__ void operator()(const f32x4 (&acc)[2][2][4][2], const Unit& u, int wr, int wc, int fr, int fq) const {
        const int row0 = u.pm * BM + wr * 64 + fr, col0 = u.pn * BM + wc * 32 + 8 * fq;
#pragma unroll
        for (int ai = 0; ai < 2; ++ai)
#pragma unroll
            for (int mp = 0; mp < 2; ++mp) {
                u32x4 hw[2][2], ew[2][2]; f32x4 qv[2];
#pragma unroll
                for (int mi = 0; mi < 2; ++mi) { const int row = row0 + ai * HALF + (2 * mp + mi) * 16; qv[mi] = *(const f32x4*)(SSQ + (size_t)row * 16 + 4 * fq);
#pragma unroll
                    for (int bj = 0; bj < 2; ++bj) { const size_t o = (size_t)row * 1024 + col0 + bj * HALF; hw[mi][bj] = *(const u32x4*)(H2 + o); ew[mi][bj] = *(const u32x4*)(EH + o); } }
#pragma unroll
                for (int mi = 0; mi < 2; ++mi) { const int m = 2 * mp + mi; const int row = row0 + ai * HALF + m * 16; const float rs = rs_from_quarter(qv[mi]); const size_t ro = (size_t)row * 1024 + col0; float ss = 0.f;
#pragma unroll
                    for (int bj = 0; bj < 2; ++bj) { const u32x4 h = hw[mi][bj], e = ew[mi][bj];
                        const f32x4 b0 = (f32x4){bf_lo(h.x), bf_hi(h.x), bf_lo(h.y), bf_hi(h.y)}, b1 = (f32x4){bf_lo(h.z), bf_hi(h.z), bf_lo(h.w), bf_hi(h.w)};
                        const f32x4 e0 = (f32x4){bf_lo(e.x), bf_hi(e.x), bf_lo(e.y), bf_hi(e.y)}, e1 = (f32x4){bf_lo(e.z), bf_hi(e.z), bf_lo(e.w), bf_hi(e.w)};
                        f32x4 v0, v1;
#pragma unroll
                        for (int j = 0; j < 4; ++j) {
                            const float g0 = __builtin_amdgcn_rcpf(1.0f + __expf(-acc[ai][bj][m][0][j] * rs)), g1 = __builtin_amdgcn_rcpf(1.0f + __expf(-acc[ai][bj][m][1][j] * rs));
                            v0[j] = b0[j] + g0 * e0[j]; v1[j] = b1[j] + g1 * e1[j]; }
                        u32x4 w; w.x = cvt_pk_bf16(v0[0], v0[1]); w.y = cvt_pk_bf16(v0[2], v0[3]); w.z = cvt_pk_bf16(v1[0], v1[1]); w.w = cvt_pk_bf16(v1[2], v1[3]);
                        *(u32x4*)(EH + ro + bj * HALF) = w;
                        ss += (v0[0] * v0[0] + v0[1] * v0[1]) + (v0[2] * v0[2] + v0[3] * v0[3]) + (v1[0] * v1[0] + v1[1] * v1[1]) + (v1[2] * v1[2] + v1[3] * v1[3]); }
                    ss += __shfl_xor(ss, 16); ss += __shfl_xor(ss, 32);
                    if (fq == 0) SSQO[(size_t)row * 16 + u.pn * 4 + wc] = ss; }
            }
    }
};
template <class Epi, class Sched, bool STAMP = false>
__device__ __forceinline__ void gemm_phase(PG8_LAS unsigned char* lds, const Gemm g, const Sched& S, const Epi& E, unsigned long long* stamps) {
    const int tid = threadIdx.x, wid = __builtin_amdgcn_readfirstlane(tid >> 6), lane = tid & 63, wr = wid >> 2, wc = wid & 3, fr = lane & 15, fq = lane >> 4;
    const int K = g.K, nt = K / BK;
    int ts_lo = 0, ts_hi = 0, nts = 0; const unsigned long long rt_entry = STAMP ? (unsigned long long)wall_clock64() : 0ull;
#define PG8_STAMP() do { if (STAMP && wid == 0 && nts < 64) { const unsigned long long _c = (unsigned long long)clock64(); \
        ts_lo = (lane == nts) ? (int)(unsigned)_c : ts_lo; ts_hi = (lane == nts) ? (int)(unsigned)(_c >> 32) : ts_hi; ++nts; } } while (0)
    PG8_STAMP();
    unsigned voffA[2], voffB[2];
#pragma unroll
    for (int i = 0; i < 2; ++i) { int R, C; stage_rc(tid * 16 + i * 8192, R, C); const int Rb = Epi::PERM ? ((R & ~31) + perm32(R & 31)) : R;
        voffA[i] = (unsigned)(R * K + C) * 2u; voffB[i] = (unsigned)(Rb * K + C) * 2u; }
    const size_t kstep = (size_t)(BK * 2);
    const size_t hstep = (size_t)HALF * K * 2;
    const size_t tstep = 2 * hstep;
    const unsigned ldsw = (unsigned)wid * 1024u;
    const int aoff = lds_byte(wr * 64 + fr, fq * 8), boff = lds_byte(wc * 32 + fr, fq * 8);
#define PG8_SA(b, h) (((b) * 2 + (h)) * HTB)
#define PG8_SB(b, h) ((4 + (b) * 2 + (h)) * HTB)
#define PG8_STAGE(bufoff, gbase, voff) do { _Pragma("unroll") for (int _i = 0; _i < 2; ++_i) \
        __builtin_amdgcn_global_load_lds((const unsigned*)((const char*)(gbase) + (voff)[_i]), (PG8_LAS unsigned*)(lds + (bufoff) + ldsw + _i * 8192), 16, 0, 0); } while (0)
#define PG8_LDA(dst, b, h) do { _Pragma("unroll") for (int m = 0; m < 4; ++m) _Pragma("unroll") for (int k = 0; k < 2; ++k) dst[m][k] = *(const PG8_LAS bf16x8*)(lds + PG8_SA(b, h) + aoff + m * 2048 + k * 1024); } while (0)
#define PG8_LDB(dst, b, h) do { _Pragma("unroll") for (int n = 0; n < 2; ++n) _Pragma("unroll") for (int k = 0; k < 2; ++k) dst[n][k] = *(const PG8_LAS bf16x8*)(lds + PG8_SB(b, h) + boff + n * 2048 + k * 1024); } while (0)
#define PG8_MMA(ai, bj, At, Bt) do { __builtin_amdgcn_s_setprio(1); _Pragma("unroll") for (int m = 0; m < 4; ++m) _Pragma("unroll") for (int n = 0; n < 2; ++n) _Pragma("unroll") for (int k = 0; k < 2; ++k) \
        acc[ai][bj][m][n] = __builtin_amdgcn_mfma_f32_16x16x32_bf16(Bt[n][k], At[m][k], acc[ai][bj][m][n], 0, 0, 0); __builtin_amdgcn_s_setprio(0); } while (0)
#define PG8_WAIT_V(n) asm volatile("s_waitcnt vmcnt(" #n ")" ::: "memory")
#define PG8_WAIT_L(n) asm volatile("s_waitcnt lgkmcnt(" #n ")" ::: "memory")
#define PG8_BAR __builtin_amdgcn_s_barrier()
#define PG8_SCHED __builtin_amdgcn_sched_barrier(0)
    Unit cur, nxt; int ui = 0;
    if (!S.next(0, cur)) return;
    f32x4 acc[2][2][4][2];
#pragma unroll
    for (int a = 0; a < 2; ++a)
#pragma unroll
        for (int b = 0; b < 2; ++b)
#pragma unroll
            for (int m = 0; m < 4; ++m)
#pragma unroll
                for (int n = 0; n < 2; ++n) acc[a][b][m][n] = (f32x4){0.f, 0.f, 0.f, 0.f};
    bf16x8 At[4][2], B0[2][2], B1[2][2];
    const char* cA = (const char*)g.A + (size_t)cur.pm * tstep; const char* cB = (const char*)g.Bt + (size_t)cur.pn * tstep;
    S.a_ready(cur);
    PG8_STAGE(PG8_SB(0, 0), cB, voffB); PG8_STAGE(PG8_SA(0, 0), cA, voffA); PG8_STAGE(PG8_SB(0, 1), cB + hstep, voffB); PG8_STAGE(PG8_SA(0, 1), cA + hstep, voffA);
    if (wr == 1) PG8_BAR;
    PG8_WAIT_V(4); PG8_BAR;
    PG8_STAGE(PG8_SB(1, 0), cB + kstep, voffB); PG8_STAGE(PG8_SA(1, 0), cA + kstep, voffA); PG8_STAGE(PG8_SB(1, 1), cB + hstep + kstep, voffB);
    PG8_WAIT_V(6); PG8_BAR;
    PG8_STAMP();
    for (;;) {
        const bool has_next = S.next(ui + 1, nxt);
        const char* nA = has_next ? (const char*)g.A + (size_t)nxt.pm * tstep : cA; const char* nB = has_next ? (const char*)g.Bt + (size_t)nxt.pn * tstep : cB;
        for (int t = 0; t < nt; t += 2) {
            const bool last = (t == nt - 2);
            const char* a1 = cA + (size_t)(t + 1) * kstep;
            const char* a2 = last ? nA : cA + (size_t)(t + 2) * kstep; const char* b2 = last ? nB : cB + (size_t)(t + 2) * kstep;
            const char* a3 = a2 + kstep; const char* b3 = b2 + kstep;
            if (last && has_next) S.a_ready(nxt);
            PG8_LDB(B0, 0, 0); PG8_SCHED; PG8_LDA(At, 0, 0); PG8_STAGE(PG8_SA(1, 1), a1 + hstep, voffA);
            PG8_WAIT_L(8); PG8_BAR; PG8_WAIT_L(0); PG8_MMA(0, 0, At, B0); PG8_BAR; PG8_SCHED;
            PG8_LDB(B1, 0, 1); PG8_STAGE(PG8_SB(0, 0), b2, voffB);
            PG8_BAR; PG8_WAIT_L(0); PG8_MMA(0, 1, At, B1); PG8_BAR;
            PG8_LDA(At, 0, 1); PG8_STAGE(PG8_SA(0, 0), a2, voffA);
            PG8_BAR; PG8_WAIT_L(0); PG8_MMA(1, 0, At, B0); PG8_BAR; PG8_SCHED;
            PG8_STAGE(PG8_SB(0, 1), b2 + hstep, voffB);
            PG8_WAIT_V(6); PG8_BAR; PG8_MMA(1, 1, At, B1); PG8_BAR;
            PG8_LDB(B0, 1, 0); PG8_SCHED; PG8_LDA(At, 1, 0); PG8_STAGE(PG8_SA(0, 1), a2 + hstep, voffA);
            PG8_WAIT_L(8); PG8_BAR; PG8_WAIT_L(0); PG8_MMA(0, 0, At, B0); PG8_BAR; PG8_SCHED;
            PG8_LDB(B1, 1, 1); PG8_STAGE(PG8_SB(1, 0), b3, voffB);
            PG8_BAR; PG8_WAIT_L(0); PG8_MMA(0, 1, At, B1); PG8_BAR;
            PG8_LDA(At, 1, 1); PG8_STAGE(PG8_SA(1, 0), a3, voffA);
            PG8_BAR; PG8_WAIT_L(0); PG8_MMA(1, 0, At, B0); PG8_BAR; PG8_SCHED;
            PG8_STAGE(PG8_SB(1, 1), b3 + hstep, voffB);
            PG8_WAIT_V(6); PG8_BAR; PG8_MMA(1, 1, At, B1); PG8_BAR;
        }
        PG8_STAMP();
        if constexpr (!Epi::AFTER_DRAIN) { E(acc, cur, wr, wc, fr, fq); S.done(cur); }
        PG8_STAMP();
        if (!has_next) break;
#pragma unroll
        for (int a = 0; a < 2; ++a)
#pragma unroll
            for (int b = 0; b < 2; ++b)
#pragma unroll
                for (int m = 0; m < 4; ++m)
#pragma unroll
                    for (int n = 0; n < 2; ++n) acc[a][b][m][n] = (f32x4){0.f, 0.f, 0.f, 0.f};
        cur = nxt; cA = nA; cB = nB; ++ui;
    }
    PG8_WAIT_V(0);
    if (wr == 0) PG8_BAR;
    PG8_BAR;
    if constexpr (Epi::AFTER_DRAIN) { E.fused(acc, cur, wr, wc, fr, fq, lds, wid, lane); S.done(cur); }
    PG8_STAMP();
    if (STAMP && wid == 0) { stamps[lane] = lane < nts ? (((unsigned long long)(unsigned)ts_hi << 32) | (unsigned)ts_lo) : 0ull;
        if (lane == 62) stamps[62] = rt_entry; if (lane == 63) stamps[63] = (unsigned long long)wall_clock64(); }
#undef PG8_STAMP
#undef PG8_SA
#undef PG8_SB
#undef PG8_STAGE
#undef PG8_LDA
#undef PG8_LDB
#undef PG8_MMA
#undef PG8_WAIT_V
#undef PG8_WAIT_L
#undef PG8_BAR
#undef PG8_SCHED
}
template <class Epi, class Sched, bool ALIGN_EPI = false, bool SP2 = false>
__device__ __forceinline__ void gemm_phase_sp(PG8_LAS unsigned char* lds, const Gemm g, const Sched& S, const Epi& E) {
    const int tid = threadIdx.x, wid = __builtin_amdgcn_readfirstlane(tid >> 6), lane = tid & 63, wr = wid >> 2, wc = wid & 3, fr = lane & 15, fq = lane >> 4;
    const int K = g.K, nt = K / BK;
    unsigned voffA[2], voffB[2];
#pragma unroll
    for (int i = 0; i < 2; ++i) { int R, C; stage_rc(tid * 16 + i * 8192, R, C); const int Rb = Epi::PERM ? ((R & ~31) + perm32(R & 31)) : R;
        voffA[i] = (unsigned)(R * K + C) * 2u; voffB[i] = (unsigned)(Rb * K + C) * 2u; }
    const size_t kstep = (size_t)(BK * 2);
    const size_t hstep = (size_t)HALF * K * 2;
    const size_t tstep = 2 * hstep;
    const unsigned ldsw = (unsigned)wid * 1024u;
    const int aoff = lds_byte(wr * 64 + fr, fq * 8), boff = lds_byte(wc * 32 + fr, fq * 8);
#define PG8_SA(b, h) (((b) * 2 + (h)) * HTB)
#define PG8_SB(b, h) ((4 + (b) * 2 + (h)) * HTB)
#define PG8_STAGE(bufoff, gbase, voff) do { _Pragma("unroll") for (int _i = 0; _i < 2; ++_i) \
        __builtin_amdgcn_global_load_lds((const unsigned*)((const char*)(gbase) + (voff)[_i]), (PG8_LAS unsigned*)(lds + (bufoff) + ldsw + _i * 8192), 16, 0, 0); } while (0)
#define PG8_LDA(dst, b, h) do { _Pragma("unroll") for (int m = 0; m < 4; ++m) _Pragma("unroll") for (int k = 0; k < 2; ++k) dst[m][k] = *(const PG8_LAS bf16x8*)(lds + PG8_SA(b, h) + aoff + m * 2048 + k * 1024); } while (0)
#define PG8_LDB(dst, b, h) do { _Pragma("unroll") for (int n = 0; n < 2; ++n) _Pragma("unroll") for (int k = 0; k < 2; ++k) dst[n][k] = *(const PG8_LAS bf16x8*)(lds + PG8_SB(b, h) + boff + n * 2048 + k * 1024); } while (0)
#define PG8_MMA(ai, bj, At, Bt) do { __builtin_amdgcn_s_setprio(1); _Pragma("unroll") for (int m = 0; m < 4; ++m) _Pragma("unroll") for (int n = 0; n < 2; ++n) _Pragma("unroll") for (int k = 0; k < 2; ++k) \
        acc[ai][bj][m][n] = __builtin_amdgcn_mfma_f32_16x16x32_bf16(Bt[n][k], At[m][k], acc[ai][bj][m][n], 0, 0, 0); __builtin_amdgcn_s_setprio(0); } while (0)
#define PG8_WAIT_V(n) asm volatile("s_waitcnt vmcnt(" #n ")" ::: "memory")
#define PG8_WAIT_L(n) asm volatile("s_waitcnt lgkmcnt(" #n ")" ::: "memory")
#define PG8_BAR __builtin_amdgcn_s_barrier()
#define PG8_SCHED __builtin_amdgcn_sched_barrier(0)
    Unit cur, nxt; int ui = 0;
    if (!S.next(0, cur)) return;
    f32x4 acc[2][2][4][2];
#pragma unroll
    for (int a = 0; a < 2; ++a)
#pragma unroll
        for (int b = 0; b < 2; ++b)
#pragma unroll
            for (int m = 0; m < 4; ++m)
#pragma unroll
                for (int n = 0; n < 2; ++n) acc[a][b][m][n] = (f32x4){0.f, 0.f, 0.f, 0.f};
    bf16x8 At[4][2], B0[2][2], B1[2][2];
    const char* cA = (const char*)g.A + (size_t)cur.pm * tstep; const char* cB = (const char*)g.Bt + (size_t)cur.pn * tstep;
    S.a_ready(cur);
    if constexpr (SP2) {
        PG8_STAGE(PG8_SB(0, 0), cB, voffB); PG8_STAGE(PG8_SB(0, 1), cB + hstep, voffB); PG8_STAGE(PG8_SA(0, 0), cA, voffA); PG8_STAGE(PG8_SA(0, 1), cA + hstep, voffA);
        if (wr == 1) PG8_BAR;
        PG8_WAIT_V(2); PG8_BAR;
        PG8_STAGE(PG8_SB(1, 0), cB + kstep, voffB); PG8_STAGE(PG8_SA(1, 0), cA + kstep, voffA); PG8_STAGE(PG8_SB(1, 1), cB + hstep + kstep, voffB);
        PG8_WAIT_V(6); PG8_BAR;
    } else {
        PG8_STAGE(PG8_SB(0, 0), cB, voffB); PG8_STAGE(PG8_SA(0, 0), cA, voffA); PG8_STAGE(PG8_SB(0, 1), cB + hstep, voffB); PG8_STAGE(PG8_SA(0, 1), cA + hstep, voffA);
        if (wr == 1) PG8_BAR;
        PG8_WAIT_V(4); PG8_BAR;
        PG8_STAGE(PG8_SB(1, 0), cB + kstep, voffB); PG8_STAGE(PG8_SA(1, 0), cA + kstep, voffA); PG8_STAGE(PG8_SB(1, 1), cB + hstep + kstep, voffB);
        PG8_WAIT_V(6); PG8_BAR;
    }
    for (;;) {
        const bool has_next = S.next(ui + 1, nxt);
        const char* nA = has_next ? (const char*)g.A + (size_t)nxt.pm * tstep : cA; const char* nB = has_next ? (const char*)g.Bt + (size_t)nxt.pn * tstep : cB;
        for (int t = 0; t < nt; t += 2) {
            const bool last = (t == nt - 2);
            const char* a1 = cA + (size_t)(t + 1) * kstep;
            const char* a2 = last ? nA : cA + (size_t)(t + 2) * kstep; const char* b2 = last ? nB : cB + (size_t)(t + 2) * kstep;
            const char* a3 = a2 + kstep; const char* b3 = b2 + kstep;
            if (last && has_next) S.a_ready(nxt);
            if constexpr (SP2) {
            PG8_LDB(B0, 0, 0); PG8_LDB(B1, 0, 1); PG8_SCHED; PG8_LDA(At, 0, 0); PG8_STAGE(PG8_SA(1, 1), a1 + hstep, voffA);
            PG8_WAIT_V(8); PG8_WAIT_L(0); PG8_BAR; PG8_MMA(0, 0, At, B0); PG8_MMA(0, 1, At, B1); PG8_BAR; PG8_SCHED;
            PG8_LDA(At, 0, 1); PG8_STAGE(PG8_SB(0, 0), b2, voffB); PG8_STAGE(PG8_SB(0, 1), b2 + hstep, voffB); PG8_STAGE(PG8_SA(0, 0), a2, voffA);
            PG8_WAIT_V(8); PG8_WAIT_L(0); PG8_BAR; PG8_MMA(1, 0, At, B0); PG8_MMA(1, 1, At, B1); PG8_BAR; PG8_SCHED;
            PG8_LDB(B0, 1, 0); PG8_LDB(B1, 1, 1); PG8_SCHED; PG8_LDA(At, 1, 0); PG8_STAGE(PG8_SA(0, 1), a2 + hstep, voffA);
            PG8_WAIT_V(8); PG8_WAIT_L(0); PG8_BAR; PG8_MMA(0, 0, At, B0); PG8_MMA(0, 1, At, B1); PG8_BAR; PG8_SCHED;
            PG8_LDA(At, 1, 1); PG8_STAGE(PG8_SB(1, 0), b3, voffB); PG8_STAGE(PG8_SB(1, 1), b3 + hstep, voffB); PG8_STAGE(PG8_SA(1, 0), a3, voffA);
            PG8_WAIT_V(8); PG8_WAIT_L(0); PG8_BAR; PG8_MMA(1, 0, At, B0); PG8_MMA(1, 1, At, B1); PG8_BAR; PG8_SCHED;
            } else {
            PG8_LDB(B0, 0, 0); PG8_SCHED; PG8_LDA(At, 0, 0); PG8_STAGE(PG8_SA(1, 1), a1 + hstep, voffA);
            PG8_WAIT_L(8); PG8_BAR; PG8_WAIT_L(0); PG8_MMA(0, 0, At, B0); PG8_BAR; PG8_SCHED;
            PG8_LDB(B1, 0, 1); PG8_STAGE(PG8_SB(0, 0), b2, voffB);
            PG8_BAR; PG8_WAIT_L(0); PG8_MMA(0, 1, At, B1); PG8_BAR;
            PG8_LDA(At, 0, 1); PG8_STAGE(PG8_SA(0, 0), a2, voffA);
            PG8_BAR; PG8_WAIT_L(0); PG8_MMA(1, 0, At, B0); PG8_BAR; PG8_SCHED;
            PG8_STAGE(PG8_SB(0, 1), b2 + hstep, voffB);
            PG8_WAIT_V(6); PG8_BAR; PG8_MMA(1, 1, At, B1); PG8_BAR;
            PG8_LDB(B0, 1, 0); PG8_SCHED; PG8_LDA(At, 1, 0); PG8_STAGE(PG8_SA(0, 1), a2 + hstep, voffA);
            PG8_WAIT_L(8); PG8_BAR; PG8_WAIT_L(0); PG8_MMA(0, 0, At, B0); PG8_BAR; PG8_SCHED;
            PG8_LDB(B1, 1, 1); PG8_STAGE(PG8_SB(1, 0), b3, voffB);
            PG8_BAR; PG8_WAIT_L(0); PG8_MMA(0, 1, At, B1); PG8_BAR;
            PG8_LDA(At, 1, 1); PG8_STAGE(PG8_SA(1, 0), a3, voffA);
            PG8_BAR; PG8_WAIT_L(0); PG8_MMA(1, 0, At, B0); PG8_BAR; PG8_SCHED;
            PG8_STAGE(PG8_SB(1, 1), b3 + hstep, voffB);
            PG8_WAIT_V(6); PG8_BAR; PG8_MMA(1, 1, At, B1); PG8_BAR;
            }
        }
        if constexpr (ALIGN_EPI) { if (wr == 0) PG8_BAR; }
        if constexpr (!Epi::AFTER_DRAIN) { E(acc, cur, wr, wc, fr, fq); S.done(cur); }
        if (!has_next) break;
#pragma unroll
        for (int a = 0; a < 2; ++a)
#pragma unroll
            for (int b = 0; b < 2; ++b)
#pragma unroll
                for (int m = 0; m < 4; ++m)
#pragma unroll
                    for (int n = 0; n < 2; ++n) acc[a][b][m][n] = (f32x4){0.f, 0.f, 0.f, 0.f};
        cur = nxt; cA = nA; cB = nB; ++ui;
        if constexpr (ALIGN_EPI) { if (wr == 1) PG8_BAR; }
    }
    PG8_WAIT_V(0);
    if constexpr (!ALIGN_EPI) { if (wr == 0) PG8_BAR; }
    PG8_BAR;
    if constexpr (Epi::AFTER_DRAIN) { E.fused(acc, cur, wr, wc, fr, fq, lds, wid, lane); S.done(cur); }
#undef PG8_SA
#undef PG8_SB
#undef PG8_STAGE
#undef PG8_LDA
#undef PG8_LDB
#undef PG8_MMA
#undef PG8_WAIT_V
#undef PG8_WAIT_L
#undef PG8_BAR
#undef PG8_SCHED
}
}
#define LAS __attribute__((address_space(3)))
typedef unsigned short bf16;
typedef float f32x4 __attribute__((ext_vector_type(4)));
typedef short bf16x8 __attribute__((ext_vector_type(8)));
typedef short bf16x4 __attribute__((ext_vector_type(4)));
typedef unsigned u32x4 __attribute__((ext_vector_type(4)));
typedef unsigned u32x2 __attribute__((ext_vector_type(2)));
constexpr int NB = 8, SEQ = 4096, DM = 1024, MT = NB * SEQ;
constexpr int NIN = 3592, NPROJ = 3584, FF = 4096, PLE = 256;
__device__ __forceinline__ size_t qkv_off(int sect, int b, int h, int t) { return ((size_t)((sect * 8 + b) * 8 + h) * 4096 + t) * 64; }
__device__ __forceinline__ size_t mp_off(int sect, int b, int h, int t) { return ((size_t)((sect * 8 + b) * 4 + h) * 4096 + t) * 128; }
constexpr size_t MiB = 1u << 20;
constexpr size_t WS_WIN = 0, WS_WOUT = 7 * MiB, WS_WUP = 9 * MiB, WS_WDN = 17 * MiB, WS_WPG = 25 * MiB, WS_WPLE = 27 * MiB;
constexpr size_t WS_PB = 28 * MiB;
constexpr size_t WS_GATES = 44 * MiB;
constexpr size_t WS_SA = 45 * MiB, WS_SR = WS_SA + 512 * 1024, WS_SB = 46 * MiB, WS_SMC = WS_SB + 512 * 1024;
constexpr size_t WS_ROPE = 47 * MiB;
constexpr size_t WS_LSE = 48 * MiB;
constexpr size_t WS_NS = 51 * MiB;
constexpr size_t WS_SSQ1 = 52 * MiB, WS_SSQ2 = 54 * MiB, WS_SSQ3 = 56 * MiB;
constexpr size_t WS_CTL = 58 * MiB, CTL_BYTES = 16384;
constexpr size_t WS_MIX = 192 * MiB;
constexpr size_t WS_G = 256 * MiB, WS_GN = 264 * MiB;
constexpr size_t WS_QC = 64 * MiB, WS_KC = 96 * MiB;
constexpr size_t WS_BUFA = 64 * MiB;
constexpr size_t WS_BUFB = 128 * MiB;
constexpr size_t WS_QKV = 192 * MiB, WS_MP = 288 * MiB;
constexpr size_t WS_OP = 416 * MiB;
constexpr size_t WS_ACT = 192 * MiB;
constexpr size_t WS_END = 512 * MiB;
constexpr int LDS_BYTES = 147456, LDS_BAR_OFF = 143360;

__device__ __forceinline__ unsigned f2bf(float f) { unsigned u = __builtin_bit_cast(unsigned, f); return (u + 0x7fffu + ((u >> 16) & 1u)) >> 16; }
__device__ __forceinline__ unsigned pk2(float lo, float hi) { return pg8::cvt_pk_bf16(lo, hi); }
__device__ __forceinline__ float bflo(unsigned w) { return __builtin_bit_cast(float, w << 16); }
__device__ __forceinline__ float bfhi(unsigned w) { return __builtin_bit_cast(float, w & 0xffff0000u); }
__device__ __forceinline__ float wave_sum(float v) {
#pragma unroll
    for (int o = 32; o >= 1; o >>= 1) v += __shfl_xor(v, o);
    return v; }
#define MFMA16(a, b, c) __builtin_amdgcn_mfma_f32_16x16x32_bf16((a), (b), (c), 0, 0, 0)

struct Params { const float* in[16]; float* out; unsigned char* ws; int ph_lo, ph_hi; };

#define XB_TMO      128
#define XB_XCNT(j)  (256  + 64 * (j))
#define XB_XSUB(j)  (1280 + 64 * (j))
#define XB_XGEN(j)  (2304 + 64 * (j))
#define XB_TOP      3328
#define XB_TOPGEN   3392
#define XCD_BAR_WORDS 3456
#define XB_SPIN_CAP (1u << 18)

__device__ __forceinline__ unsigned xb_ld(unsigned* p)              { return __hip_atomic_load(p, __ATOMIC_RELAXED, __HIP_MEMORY_SCOPE_AGENT); }
__device__ __forceinline__ unsigned xb_add(unsigned* p, unsigned v) { return __hip_atomic_fetch_add(p, v, __ATOMIC_RELAXED, __HIP_MEMORY_SCOPE_AGENT); }
__device__ __forceinline__ unsigned xb_xcc_id() { return (unsigned)__builtin_amdgcn_s_getreg((3 << 11) | 20) & 0xFu; }
#define XB_SPIN(cond, bar) do { unsigned _sp = 0; while (cond) { __builtin_amdgcn_s_sleep(1); \
    if ((++_sp & 255u) == 0u) { if (xb_ld(&(bar)[XB_TMO])) break; if (_sp > XB_SPIN_CAP) { atomicAdd(&(bar)[XB_TMO], 1u); break; } } } } while (0)

struct XcdBarrier {
    unsigned* bar; unsigned x;
    volatile LAS unsigned* st;
};

__device__ __forceinline__ XcdBarrier xcd_barrier_post(unsigned* bar, volatile LAS unsigned* st) {
    XcdBarrier b; b.bar = bar; b.x = xb_xcc_id(); b.st = st;
    if (threadIdx.x == 0) (void)xb_add(&bar[XB_XCNT(b.x)], 1u);
    return b;
}
__device__ __forceinline__ void xcd_barrier_complete(unsigned* bar, unsigned x, unsigned& nloc, unsigned& nx) {
    const unsigned G = gridDim.x * gridDim.y * gridDim.z;
    unsigned sum, cnt, mine, sp = 0u;
    for (;;) {
        sum = 0u; cnt = 0u; mine = 0u;
#pragma unroll
        for (unsigned j = 0; j < 16; ++j) { const unsigned c = xb_ld(&bar[XB_XCNT(j)]); sum += c; cnt += (c > 0u) ? 1u : 0u; mine = (j == x) ? c : mine; }
        if (sum == G) break;
        __builtin_amdgcn_s_sleep(1);
        if ((++sp & 255u) == 0u) { if (xb_ld(&bar[XB_TMO])) break; if (sp > XB_SPIN_CAP) { atomicAdd(&bar[XB_TMO], 1u); break; } }
    }
    nloc = mine > 0u ? mine : 1u; nx = cnt > 0u ? cnt : 1u;
}

__device__ __forceinline__ void xcd_barrier(const XcdBarrier& b) {
    asm volatile("s_waitcnt vmcnt(0)" ::: "memory");
    __syncthreads();
    if (threadIdx.x == 0) {
        unsigned* bar = b.bar;
        __builtin_amdgcn_s_waitcnt(0);
        unsigned nloc = b.st[0], nx = b.st[1];
        if (nloc == 0u) { xcd_barrier_complete(bar, b.x, nloc, nx); b.st[0] = nloc; b.st[1] = nx; }
        const unsigned old = xb_add(&bar[XB_XSUB(b.x)], 1u);
        const unsigned gen = old / nloc;
        if (old + 1u == (gen + 1u) * nloc) {
            __builtin_amdgcn_fence(__ATOMIC_RELEASE, "agent");
            asm volatile("s_waitcnt vmcnt(0)" ::: "memory");
            const unsigned og = xb_add(&bar[XB_TOP], 1u);
            const unsigned tg = og / nx;
            if (og + 1u == (tg + 1u) * nx) xb_add(&bar[XB_TOPGEN], 1u);
            else XB_SPIN(xb_ld(&bar[XB_TOPGEN]) == tg, bar);
            __builtin_amdgcn_fence(__ATOMIC_ACQUIRE, "agent");
            xb_add(&bar[XB_XGEN(b.x)], 1u);
            asm volatile("s_waitcnt vmcnt(0)" ::: "memory");
        } else {
            XB_SPIN(xb_ld(&bar[XB_XGEN(b.x)]) == gen, bar);
            __builtin_amdgcn_fence(__ATOMIC_ACQUIRE, "agent");
            asm volatile("s_waitcnt vmcnt(0)" ::: "memory");
        }
    }
    __syncthreads();
}


struct TItem { const float* W; const float* g; bf16* Wt; int Nsrc, K, k0, n0; };
__device__ __forceinline__ TItem t_decode(const Params& P, int it) {
    constexpr int I_IN = 16 * 56, I_OUT = 16 * 16, I_UP = 16 * 64, I_DN = 64 * 16, I_PG = 16 * 16;
    unsigned char* ws = P.ws; TItem t; int r = it;
    if (r < I_IN) { t = TItem{P.in[3], nullptr, (bf16*)(ws + WS_WIN), NIN, 1024, (r & 15) * 64, (r >> 4) * 64}; return t; } r -= I_IN;
    if (r < I_OUT) { t = TItem{P.in[8], nullptr, (bf16*)(ws + WS_WOUT), 1024, 1024, (r & 15) * 64, (r >> 4) * 64}; return t; } r -= I_OUT;
    if (r < I_UP) { t = TItem{P.in[10], P.in[9], (bf16*)(ws + WS_WUP), 4096, 1024, (r & 15) * 64, (r >> 4) * 64}; return t; } r -= I_UP;
    if (r < I_DN) { t = TItem{P.in[11], nullptr, (bf16*)(ws + WS_WDN), 1024, 4096, (r & 63) * 64, (r >> 6) * 64}; return t; } r -= I_DN;
    if (r < I_PG) { t = TItem{P.in[13], P.in[12], (bf16*)(ws + WS_WPG), 1024, 1024, (r & 15) * 64, (r >> 4) * 64}; return t; } r -= I_PG;
    t = TItem{P.in[14], nullptr, (bf16*)(ws + WS_WPLE), 1024, 256, (r & 3) * 64, (r >> 2) * 64}; return t;
}
__device__ __forceinline__ void t_load(const TItem& t, f32x4 (&v)[2]) {
    const int tid = threadIdx.x;
#pragma unroll
    for (int pass = 0; pass < 2; ++pass) { const int kk = (tid >> 4) + pass * 32, nn = (tid & 15) * 4;
        v[pass] = *(const f32x4*)(t.W + (size_t)(t.k0 + kk) * t.Nsrc + t.n0 + nn); const float gs = t.g ? t.g[t.k0 + kk] : 1.0f; v[pass] = v[pass] * gs; }
}
__device__ __forceinline__ void t_store(const TItem& t, const f32x4 (&v)[2], LAS float* tile) {
    const int tid = threadIdx.x;
#pragma unroll
    for (int pass = 0; pass < 2; ++pass) { const int kk = (tid >> 4) + pass * 32, nn = (tid & 15) * 4;
        tile[kk * 65 + nn + 0] = v[pass][0]; tile[kk * 65 + nn + 1] = v[pass][1]; tile[kk * 65 + nn + 2] = v[pass][2]; tile[kk * 65 + nn + 3] = v[pass][3]; }
    __syncthreads();
    { const int n = tid >> 3, kc = (tid & 7) * 8; u32x4 w;
      w.x = pk2(tile[(kc + 0) * 65 + n], tile[(kc + 1) * 65 + n]); w.y = pk2(tile[(kc + 2) * 65 + n], tile[(kc + 3) * 65 + n]);
      w.z = pk2(tile[(kc + 4) * 65 + n], tile[(kc + 5) * 65 + n]); w.w = pk2(tile[(kc + 6) * 65 + n], tile[(kc + 7) * 65 + n]);
      *(u32x4*)(t.Wt + (size_t)(t.n0 + n) * t.K + t.k0 + kc) = w; }
    __syncthreads();
}
__device__ __forceinline__ float reduce8(float (&a)[8], int lane) {
    float b[4], c[2], d;
#pragma unroll
    for (int j = 0; j < 4; ++j) { const float keep = (lane & 1) ? a[2 * j + 1] : a[2 * j], send = (lane & 1) ? a[2 * j] : a[2 * j + 1]; b[j] = keep + __shfl_xor(send, 1); }
#pragma unroll
    for (int j = 0; j < 2; ++j) { const float keep = (lane & 2) ? b[2 * j + 1] : b[2 * j], send = (lane & 2) ? b[2 * j] : b[2 * j + 1]; c[j] = keep + __shfl_xor(send, 2); }
    { const float keep = (lane & 4) ? c[1] : c[0], send = (lane & 4) ? c[0] : c[1]; d = keep + __shfl_xor(send, 4); }
    d += __shfl_xor(d, 8); d += __shfl_xor(d, 16); d += __shfl_xor(d, 32);
    return d;
}
__device__ __forceinline__ void p0_prologue(const Params& P, LAS unsigned char* lds) {
    const int tid = threadIdx.x, lane = tid & 63, wave = tid >> 6, G = gridDim.x, bx = blockIdx.x;
    unsigned char* ws = P.ws;
    LAS float* tile = (LAS float*)lds;
    LAS float* wg = (LAS float*)(lds + 32768);
    { const float* w_in = P.in[3]; const float* gm = P.in[2];
      for (int k = tid; k < 1024; k += 512) { const f32x4 a = *(const f32x4*)(w_in + (size_t)k * NIN + NPROJ), c = *(const f32x4*)(w_in + (size_t)k * NIN + NPROJ + 4); const float gk = gm[k];
          wg[0 * 1024 + k] = a[0] * gk; wg[1 * 1024 + k] = a[1] * gk; wg[2 * 1024 + k] = a[2] * gk; wg[3 * 1024 + k] = a[3] * gk;
          wg[4 * 1024 + k] = c[0] * gk; wg[5 * 1024 + k] = c[1] * gk; wg[6 * 1024 + k] = c[2] * gk; wg[7 * 1024 + k] = c[3] * gk; } }
    { constexpr int NIT = 16 * 56 + 16 * 16 + 16 * 64 + 64 * 16 + 16 * 16 + 4 * 16;
      int it = bx;
      if (it < NIT) { TItem cur = t_decode(P, it); f32x4 v[2]; t_load(cur, v);
          for (;;) { const int nx = it + G; const bool has = nx < NIT; TItem nt = cur; f32x4 w[2] = {v[0], v[1]};
              if (has) { nt = t_decode(P, nx); t_load(nt, w); }
              t_store(cur, v, tile);
              if (!has) break;
              cur = nt; v[0] = w[0]; v[1] = w[1]; it = nx; } } }
    __syncthreads();
    { const float* x = P.in[0]; const float* gm = P.in[2]; const float* gate_b = P.in[6];
      bf16* U = (bf16*)(ws + WS_BUFA); float* GT = (float*)(ws + WS_GATES);
      f32x4 gv[4];
#pragma unroll
      for (int j = 0; j < 4; ++j) gv[j] = ((const f32x4*)gm)[lane + 64 * j];
      const float gb = gate_b[lane & 7];
      for (int row0 = (bx * 8 + wave) * 2; row0 < MT; row0 += G * 16) {
          f32x4 xv[2][4];
#pragma unroll
          for (int r = 0; r < 2; ++r)
#pragma unroll
              for (int j = 0; j < 4; ++j) xv[r][j] = ((const f32x4*)(x + (size_t)(row0 + r) * DM))[lane + 64 * j];
#pragma unroll
          for (int r = 0; r < 2; ++r) { const int row = row0 + r; float ss = 0.f;
#pragma unroll
              for (int j = 0; j < 4; ++j) ss += (xv[r][j][0] * xv[r][j][0] + xv[r][j][1] * xv[r][j][1]) + (xv[r][j][2] * xv[r][j][2] + xv[r][j][3] * xv[r][j][3]);
              ss = wave_sum(ss);
              const float rs = 1.0f / sqrtf(ss * (1.0f / DM) + 1e-6f);
#pragma unroll
              for (int j = 0; j < 4; ++j) { const f32x4 o = xv[r][j] * rs * gv[j]; u32x2 w; w.x = pk2(o[0], o[1]); w.y = pk2(o[2], o[3]);
                  *(u32x2*)(U + (size_t)row * DM + (lane + 64 * j) * 4) = w; }
              float ga[8];
#pragma unroll
              for (int gj = 0; gj < 8; ++gj) { float a = 0.f;
#pragma unroll
                  for (int j = 0; j < 4; ++j) { const f32x4 wv = ((const LAS f32x4*)(wg + gj * 1024))[lane + 64 * j]; a += (xv[r][j][0] * wv[0] + xv[r][j][1] * wv[1]) + (xv[r][j][2] * wv[2] + xv[r][j][3] * wv[3]); }
                  ga[gj] = a; }
              const float myg = reduce8(ga, lane);
              if (lane < 8) GT[(size_t)row * 8 + lane] = myg * rs + gb; }
      } }
    { const f32x4* p4 = (const f32x4*)P.in[1]; u32x2* pb = (u32x2*)(ws + WS_PB); const size_t n4 = (size_t)MT * PLE / 4, step = (size_t)G * 512;
      for (size_t i0 = (size_t)bx * 512 + tid; i0 < n4; i0 += 4 * step) { f32x4 v[4];
#pragma unroll
          for (int q = 0; q < 4; ++q) if (i0 + q * step < n4) v[q] = p4[i0 + q * step];
#pragma unroll
          for (int q = 0; q < 4; ++q) if (i0 + q * step < n4) { u32x2 w; w.x = pk2(v[q][0], v[q][1]); w.y = pk2(v[q][2], v[q][3]); pb[i0 + q * step] = w; } } }
    { float* rc = (float*)(ws + WS_ROPE); float* rsn = rc + 4096 * 8;
      for (int i = bx * 512 + tid; i < 4096 * 8; i += G * 512) { const int pos = i >> 3, f = i & 7; const float inv = powf(500000.0f, -(float)f * 0.125f); const float ang = (float)pos * inv;
          rc[i] = cosf(ang); rsn[i] = sinf(ang); } }
}

__device__ __forceinline__ void gate_scan(const Params& P, int bh, LAS unsigned char* lds) {
    const int tid = threadIdx.x, lane = tid & 63, wave = tid >> 6; const int b = bh >> 2, h = bh & 3;
    unsigned char* ws = P.ws; const float* GT = (const float*)(ws + WS_GATES);
    float* SA = (float*)(ws + WS_SA); float* SR = (float*)(ws + WS_SR); float* SB = (float*)(ws + WS_SB); float* SMC = (float*)(ws + WS_SMC);
    LAS float* sm = (LAS float*)lds;
    float a_[8], b_[8], cm_[8];
#pragma unroll
    for (int j = 0; j < 8; ++j) { const int c = wave + 8 * j, t = c * 64 + lane; const float* gp = GT + (size_t)(b * SEQ + t) * 8;
        const float ip = gp[h], fp = gp[4 + h];
        const float lf = fminf(fp, 0.f) - log1pf(expf(-fabsf(fp)));
        float s = lf;
#pragma unroll
        for (int o = 1; o < 64; o <<= 1) { const float v = __shfl_up(s, o); if (lane >= o) s += v; }
        const float a = ip - s; float cm = a;
#pragma unroll
        for (int o = 1; o < 64; o <<= 1) { const float v = __shfl_up(cm, o); if (lane >= o) cm = fmaxf(cm, v); }
        a_[j] = a; b_[j] = s; cm_[j] = cm;
        if (lane == 63) { sm[c] = s; sm[64 + c] = cm; } }
    __syncthreads();
    if (tid < 64) {
        const float blv = sm[lane], amv = sm[64 + lane]; float m = 0.f, mcv = 0.f;
#pragma unroll 8
        for (int c = 0; c < 64; ++c) { mcv = (lane == c) ? m : mcv;
            m = __builtin_bit_cast(float, __builtin_amdgcn_readlane(__builtin_bit_cast(int, blv), c)) + fmaxf(m, __builtin_bit_cast(float, __builtin_amdgcn_readlane(__builtin_bit_cast(int, amv), c))); }
        sm[128 + lane] = mcv; }
    __syncthreads();
#pragma unroll
    for (int j = 0; j < 8; ++j) { const int c = wave + 8 * j, t = c * 64 + lane; const float mc = sm[128 + c];
        SA[bh * SEQ + t] = a_[j]; SR[bh * SEQ + t] = fmaxf(mc, cm_[j]); SB[bh * SEQ + t] = b_[j]; if (lane == 0) SMC[bh * 64 + c] = mc; }
    __syncthreads();
}

constexpr int AQ_STRIDE = 144, AV_STRIDE = 792;
constexpr int A_Q0 = 0, A_QB = 128 * AQ_STRIDE, A_KOFF = 2 * A_QB, A_KSLOT = 128 * AQ_STRIDE, A_VOFF = A_KOFF + 3 * A_KSLOT;
struct AttnItem { int pi, b, h, r, n, dsh; };
__device__ __forceinline__ AttnItem attn_decode(int it) { AttnItem a; const int bh = it / 96, rem = it - bh * 96, jj = rem & 31; a.pi = rem >> 5; a.b = bh >> 3; a.h = bh & 7; a.dsh = 2 * a.pi;
    const int nbsh = 5 - 2 * a.pi; a.r = jj >> nbsh; a.n = jj & ((1 << nbsh) - 1); return a; }
struct AttnRegs { u32x4 q0, q1, k0, k1, va, vb; };
__device__ __forceinline__ void attn_load_kv(const bf16* proj, const AttnItem& a, int nblk, AttnRegs& R) {
    const int tid = threadIdx.x, qi = tid >> 2, dc = tid & 3, kp = tid & 63, dg = tid >> 6;
    const int pos = ((nblk * 128 + qi) << a.dsh) + a.r; const bf16* ks = proj + qkv_off(1, a.b, a.h, pos) + dc * 16;
    R.k0 = *(const u32x4*)ks; R.k1 = *(const u32x4*)(ks + 8);
    const bf16* vs = proj + qkv_off(2, a.b, a.h, pos) + dc * 16;
    R.va = *(const u32x4*)vs; R.vb = *(const u32x4*)(vs + 8);
}
__device__ __forceinline__ void attn_load_q(const bf16* proj, const AttnItem& a, AttnRegs& R) {
    const int tid = threadIdx.x, qi = tid >> 2, dc = tid & 3; const int pos = ((a.n * 128 + qi) << a.dsh) + a.r;
    const bf16* qs = proj + qkv_off(0, a.b, a.h, pos) + dc * 16; R.q0 = *(const u32x4*)qs; R.q1 = *(const u32x4*)(qs + 8);
}
__device__ __forceinline__ void attn_commit_kv(LAS unsigned char* lds, int slot, const AttnRegs& R) {
    const int tid = threadIdx.x, qi = tid >> 2, dc = tid & 3, kp = tid & 63, dg = tid >> 6;
    *(LAS u32x4*)(lds + A_KOFF + slot * A_KSLOT + qi * AQ_STRIDE + dc * 32) = R.k0; *(LAS u32x4*)(lds + A_KOFF + slot * A_KSLOT + qi * AQ_STRIDE + dc * 32 + 16) = R.k1;
    { const int odd = qi & 1, kp2 = qi >> 1;
      const u32x4 snd = odd ? R.va : R.vb; u32x4 rcv;
      rcv.x = __shfl_xor(snd.x, 4); rcv.y = __shfl_xor(snd.y, 4); rcv.z = __shfl_xor(snd.z, 4); rcv.w = __shfl_xor(snd.w, 4);
      const u32x4 ka = odd ? rcv : R.va, kb = odd ? R.vb : rcv;
      LAS unsigned char* vt = lds + A_VOFF + (dc * 16 + odd * 8) * AV_STRIDE + slot * 256 + kp2 * 4;
      *(LAS unsigned*)(vt + 0 * AV_STRIDE) = (ka.x & 0xffffu) | (kb.x << 16); *(LAS unsigned*)(vt + 1 * AV_STRIDE) = (ka.x >> 16) | (kb.x & 0xffff0000u);
      *(LAS unsigned*)(vt + 2 * AV_STRIDE) = (ka.y & 0xffffu) | (kb.y << 16); *(LAS unsigned*)(vt + 3 * AV_STRIDE) = (ka.y >> 16) | (kb.y & 0xffff0000u);
      *(LAS unsigned*)(vt + 4 * AV_STRIDE) = (ka.z & 0xffffu) | (kb.z << 16); *(LAS unsigned*)(vt + 5 * AV_STRIDE) = (ka.z >> 16) | (kb.z & 0xffff0000u);
      *(LAS unsigned*)(vt + 6 * AV_STRIDE) = (ka.w & 0xffffu) | (kb.w << 16); *(LAS unsigned*)(vt + 7 * AV_STRIDE) = (ka.w >> 16) | (kb.w & 0xffff0000u); }
}
__device__ __forceinline__ void attn_commit_q(LAS unsigned char* lds, int qb, const AttnRegs& R) {
    const int tid = threadIdx.x, qi = tid >> 2, dc = tid & 3;
    *(LAS u32x4*)(lds + A_Q0 + qb * A_QB + qi * AQ_STRIDE + dc * 32) = R.q0; *(LAS u32x4*)(lds + A_Q0 + qb * A_QB + qi * AQ_STRIDE + dc * 32 + 16) = R.q1;
}
__device__ __forceinline__ void attn_compute(const Params& P, const AttnItem& a, int qb, int sprev, int scur, LAS unsigned char* lds) {
    const int tid = threadIdx.x, lane = tid & 63, wave = tid >> 6, fr = lane & 15, g = lane >> 4; unsigned char* ws = P.ws; const int n = a.n;
    const int q0 = wave * 16;
    bf16x8 qf[2];
#pragma unroll
    for (int ks = 0; ks < 2; ++ks) qf[ks] = *(const LAS bf16x8*)(lds + A_Q0 + qb * A_QB + (q0 + fr) * AQ_STRIDE + ks * 64 + g * 16);
    f32x4 sc[9];
    __builtin_amdgcn_s_setprio(1);
#pragma unroll
    for (int nt = 0; nt < 9; ++nt) { f32x4 acc = (f32x4){0.f, 0.f, 0.f, 0.f}; const int ki0 = q0 + 16 * nt; const int slot = (ki0 < 128) ? sprev : scur;
#pragma unroll
        for (int ks = 0; ks < 2; ++ks) { const bf16x8 kf = *(const LAS bf16x8*)(lds + A_KOFF + slot * A_KSLOT + ((ki0 & 127) + fr) * AQ_STRIDE + ks * 64 + g * 16); acc = MFMA16(kf, qf[ks], acc); }
        sc[nt] = acc; }
    __builtin_amdgcn_s_setprio(0);
    const float SC2 = 0.125f * 1.4426950408889634f;
    float mx = -INFINITY;
#pragma unroll
    for (int nt = 0; nt < 9; ++nt) { const bool tile_ok = (n > 0) || (q0 + 16 * nt >= 128);
#pragma unroll
        for (int i = 0; i < 4; ++i) { bool ok = tile_ok; if (nt == 0) ok = ok && (4 * g + i >= fr); if (nt == 8) ok = ok && (4 * g + i <= fr);
            const float sv = ok ? sc[nt][i] * SC2 : -INFINITY; sc[nt][i] = sv; mx = fmaxf(mx, sv); } }
    mx = fmaxf(mx, __shfl_xor(mx, 16)); mx = fmaxf(mx, __shfl_xor(mx, 32));
    float den = 0.f;
#pragma unroll
    for (int nt = 0; nt < 9; ++nt)
#pragma unroll
        for (int i = 0; i < 4; ++i) { const float p = __builtin_amdgcn_exp2f(sc[nt][i] - mx); sc[nt][i] = p; den += p; }
    den += __shfl_xor(den, 16); den += __shfl_xor(den, 32);
    bf16x8 pf[5];
#pragma unroll
    for (int ks = 0; ks < 5; ++ks) { u32x4 w; w.x = pg8::cvt_pk_bf16(sc[2 * ks][0], sc[2 * ks][1]); w.y = pg8::cvt_pk_bf16(sc[2 * ks][2], sc[2 * ks][3]);
        if (ks < 4) { w.z = pg8::cvt_pk_bf16(sc[2 * ks + 1][0], sc[2 * ks + 1][1]); w.w = pg8::cvt_pk_bf16(sc[2 * ks + 1][2], sc[2 * ks + 1][3]); } else { w.z = 0u; w.w = 0u; }
        pf[ks] = __builtin_bit_cast(bf16x8, w); }
    const float inv = __builtin_amdgcn_rcpf(den);
    const int posq = ((n * 128 + q0 + fr) << a.dsh) + a.r; const size_t tokbase = (size_t)a.b * SEQ;
    bf16* OP = (bf16*)(ws + WS_OP) + (size_t)a.pi * MT * 512 + (tokbase + posq) * 512 + a.h * 64;
    __builtin_amdgcn_s_setprio(1);
#pragma unroll
    for (int et = 0; et < 4; ++et) { f32x4 o = (f32x4){0.f, 0.f, 0.f, 0.f};
#pragma unroll
        for (int ks = 0; ks < 5; ++ks) { const int kb0 = q0 + 32 * ks, kb1 = kb0 + 16;
            const LAS unsigned char* vrow = lds + A_VOFF + (et * 16 + fr) * AV_STRIDE + (4 * g) * 2;
            const u32x2 v0 = *(const LAS u32x2*)(vrow + ((kb0 < 128) ? sprev : scur) * 256 + (kb0 & 127) * 2); u32x2 v1 = (u32x2){0u, 0u};
            if (ks < 4) v1 = *(const LAS u32x2*)(vrow + ((kb1 < 128) ? sprev : scur) * 256 + (kb1 & 127) * 2);
            const u32x4 vw = (u32x4){v0.x, v0.y, v1.x, v1.y};
            o = MFMA16(__builtin_bit_cast(bf16x8, vw), pf[ks], o); }
        u32x2 w; w.x = pg8::cvt_pk_bf16(o[0] * inv, o[1] * inv); w.y = pg8::cvt_pk_bf16(o[2] * inv, o[3] * inv);
        *(u32x2*)(OP + et * 16 + 4 * g) = w; }
    __builtin_amdgcn_s_setprio(0);
    if (g == 0) ((float*)(ws + WS_LSE))[(size_t)a.pi * MT * 8 + (tokbase + posq) * 8 + a.h] = mx * 0.6931471805599453f + logf(den);
}
__device__ __forceinline__ void attn_phase(const Params& P, LAS unsigned char* lds) {
    const int G = gridDim.x, per = (6144 + G - 1) / G; const int bxv = (G % 8 == 0) ? (blockIdx.x & 7) * (G / 8) + (blockIdx.x >> 3) : blockIdx.x;
    const int it0 = bxv * per, it1 = (it0 + per < 6144) ? it0 + per : 6144;
    if (it0 >= it1) return;
    const bf16* proj = (const bf16*)(P.ws + WS_QKV);
    AttnRegs RA, RB;
    { const AttnItem a = attn_decode(it0);
      if (a.n > 0) { attn_load_kv(proj, a, a.n - 1, RA); attn_commit_kv(lds, 2, RA); }
      else { RA.k0 = (u32x4){0u, 0u, 0u, 0u}; RA.k1 = RA.k0; RA.va = RA.k0; RA.vb = RA.k0; attn_commit_kv(lds, 2, RA); }
      attn_load_kv(proj, a, a.n, RA); attn_load_q(proj, a, RA); attn_commit_kv(lds, 0, RA); attn_commit_q(lds, 0, RA); }
    if (it0 + 1 < it1) { const AttnItem an = attn_decode(it0 + 1); attn_load_kv(proj, an, an.n, RA); attn_load_q(proj, an, RA); }
    __syncthreads();
    int i3 = 0;
    for (int it = it0; it < it1; it += 2) {
        { const AttnItem a = attn_decode(it);
          if (it + 2 < it1) { const AttnItem an = attn_decode(it + 2); attn_load_kv(proj, an, an.n, RB); attn_load_q(proj, an, RB); }
          const int scur = i3, sprev = (i3 == 0) ? 2 : i3 - 1, snext = (i3 == 2) ? 0 : i3 + 1;
          attn_compute(P, a, 0, sprev, scur, lds);
          if (it + 1 < it1) { attn_commit_kv(lds, snext, RA); attn_commit_q(lds, 1, RA); }
          __syncthreads();
          i3 = snext; }
        if (it + 1 >= it1) break;
        { const AttnItem a = attn_decode(it + 1);
          if (it + 3 < it1) { const AttnItem an = attn_decode(it + 3); attn_load_kv(proj, an, an.n, RA); attn_load_q(proj, an, RA); }
          const int scur = i3, sprev = (i3 == 0) ? 2 : i3 - 1, snext = (i3 == 2) ? 0 : i3 + 1;
          attn_compute(P, a, 1, sprev, scur, lds);
          if (it + 2 < it1) { attn_commit_kv(lds, snext, RB); attn_commit_q(lds, 0, RB); }
          __syncthreads();
          i3 = snext; }
    }
}

__device__ __forceinline__ void conv_silu2(const u32x4 (&xr)[5], const float* cw  , const float* cb, int ch, float scale, float (&o0)[8], float (&o1)[8]) {
    float xv[5][8];
#pragma unroll
    for (int i = 0; i < 5; ++i) { xv[i][0] = bflo(xr[i].x); xv[i][1] = bfhi(xr[i].x); xv[i][2] = bflo(xr[i].y); xv[i][3] = bfhi(xr[i].y); xv[i][4] = bflo(xr[i].z); xv[i][5] = bfhi(xr[i].z); xv[i][6] = bflo(xr[i].w); xv[i][7] = bfhi(xr[i].w); }
    float wv[4][8], bv[8];
#pragma unroll
    for (int j = 0; j < 4; ++j) { const f32x4 a = *(const f32x4*)(cw + j * 1024 + ch), c = *(const f32x4*)(cw + j * 1024 + ch + 4);
        wv[j][0] = a[0]; wv[j][1] = a[1]; wv[j][2] = a[2]; wv[j][3] = a[3]; wv[j][4] = c[0]; wv[j][5] = c[1]; wv[j][6] = c[2]; wv[j][7] = c[3]; }
    { const f32x4 a = *(const f32x4*)(cb + ch), c = *(const f32x4*)(cb + ch + 4); bv[0] = a[0]; bv[1] = a[1]; bv[2] = a[2]; bv[3] = a[3]; bv[4] = c[0]; bv[5] = c[1]; bv[6] = c[2]; bv[7] = c[3]; }
#pragma unroll
    for (int e = 0; e < 8; ++e) {
        float s0 = bv[e], s1 = bv[e];
#pragma unroll
        for (int j = 0; j < 4; ++j) { s0 += wv[j][e] * xv[j][e]; s1 += wv[j][e] * xv[j + 1][e]; }
        o0[e] = s0 * __builtin_amdgcn_rcpf(1.0f + __expf(-s0)) * scale; o1[e] = s1 * __builtin_amdgcn_rcpf(1.0f + __expf(-s1)) * scale; }
}
__device__ __forceinline__ void conv_silu4(const u32x4 (&xr)[7], const float* cw  , const float* cb, int ch, float scale, float (&o)[4][8]) {
    float wv[4][8], bv[8];
#pragma unroll
    for (int j = 0; j < 4; ++j) { const f32x4 a = *(const f32x4*)(cw + j * 1024 + ch), c = *(const f32x4*)(cw + j * 1024 + ch + 4);
        wv[j][0] = a[0]; wv[j][1] = a[1]; wv[j][2] = a[2]; wv[j][3] = a[3]; wv[j][4] = c[0]; wv[j][5] = c[1]; wv[j][6] = c[2]; wv[j][7] = c[3]; }
    { const f32x4 a = *(const f32x4*)(cb + ch), c = *(const f32x4*)(cb + ch + 4); bv[0] = a[0]; bv[1] = a[1]; bv[2] = a[2]; bv[3] = a[3]; bv[4] = c[0]; bv[5] = c[1]; bv[6] = c[2]; bv[7] = c[3]; }
    float xv[7][8];
#pragma unroll
    for (int i = 0; i < 7; ++i) { xv[i][0] = bflo(xr[i].x); xv[i][1] = bfhi(xr[i].x); xv[i][2] = bflo(xr[i].y); xv[i][3] = bfhi(xr[i].y); xv[i][4] = bflo(xr[i].z); xv[i][5] = bfhi(xr[i].z); xv[i][6] = bflo(xr[i].w); xv[i][7] = bfhi(xr[i].w); }
#pragma unroll
    for (int t = 0; t < 4; ++t)
#pragma unroll
        for (int e = 0; e < 8; ++e) { float a = bv[e];
#pragma unroll
            for (int j = 0; j < 4; ++j) a += wv[j][e] * xv[t + j][e];
            o[t][e] = a * __builtin_amdgcn_rcpf(1.0f + __expf(-a)) * scale; }
}
__device__ __forceinline__ void load7(const bf16* mp, int sect, int b, int h, int t0, int ch, u32x4 (&xr)[7]) {
    const bf16* base = mp + mp_off(sect, b, h, 0) + ch;
#pragma unroll
    for (int i = 0; i < 7; ++i) { const int t = t0 - 3 + i; xr[i] = (u32x4){0u, 0u, 0u, 0u};
        if (t >= 0) xr[i] = *(const u32x4*)(base + (size_t)t * 128); }
}
__device__ __forceinline__ void load5(const bf16* mp, int sect, int b, int h, int t0, int ch, u32x4 (&xr)[5]) {
    const bf16* base = mp + mp_off(sect, b, h, 0) + ch;
#pragma unroll
    for (int i = 0; i < 5; ++i) { const int t = t0 - 3 + i; xr[i] = (u32x4){0u, 0u, 0u, 0u};
        if (t >= 0) xr[i] = *(const u32x4*)(base + (size_t)t * 128); }
}
constexpr int T72 = 144, T136 = 272;
__device__ __forceinline__ void stage_vt(const bf16* proj, int b, int h, int t0, LAS unsigned char* vt) {
    const int tid = threadIdx.x, eg = tid >> 5, tg = tid & 31;
    const bf16* s0 = proj + mp_off(2, b, h, t0 + 2 * tg) + eg * 8;
    const u32x4 va = *(const u32x4*)s0, vb = *(const u32x4*)(s0 + 128);
    LAS unsigned char* d = vt + (eg * 8) * T72 + tg * 4;
    *(LAS unsigned*)(d + 0 * T72) = (va.x & 0xffffu) | (vb.x << 16); *(LAS unsigned*)(d + 1 * T72) = (va.x >> 16) | (vb.x & 0xffff0000u);
    *(LAS unsigned*)(d + 2 * T72) = (va.y & 0xffffu) | (vb.y << 16); *(LAS unsigned*)(d + 3 * T72) = (va.y >> 16) | (vb.y & 0xffff0000u);
    *(LAS unsigned*)(d + 4 * T72) = (va.z & 0xffffu) | (vb.z << 16); *(LAS unsigned*)(d + 5 * T72) = (va.z >> 16) | (vb.z & 0xffff0000u);
    *(LAS unsigned*)(d + 6 * T72) = (va.w & 0xffffu) | (vb.w << 16); *(LAS unsigned*)(d + 7 * T72) = (va.w >> 16) | (vb.w & 0xffff0000u);
}

struct LBig { u32x4 xr[7], va, vb; };
__device__ __forceinline__ void mlstm_local_load(const Params& P, int item, LBig& R) {
    const int tid = threadIdx.x; const int bh = item >> 6, c = item & 63, b = bh >> 2, h = bh & 3, t0 = c * 64; const bf16* proj = (const bf16*)(P.ws + WS_MP);
    if (tid < 256) { const int cgp = tid & 15, tg = tid >> 4; load7(proj, 0, b, h, t0 + 4 * tg, cgp * 8, R.xr); }
    else { const int idx = tid - 256, tg = idx & 15, cgp = idx >> 4; load7(proj, 1, b, h, t0 + 4 * tg, cgp * 8, R.xr); }
    { const int eg = tid >> 5, tg = tid & 31; const bf16* s0 = proj + mp_off(2, b, h, t0 + 2 * tg) + eg * 8; R.va = *(const u32x4*)s0; R.vb = *(const u32x4*)(s0 + 128); }
}
__device__ __forceinline__ void mlstm_local_item(const Params& P, int item, int next, bool first, float& nrun, LBig& R, LAS unsigned char* lds) {
    const int tid = threadIdx.x, lane = tid & 63, wave = tid >> 6, fr = lane & 15, g = lane >> 4;
    const int bh = item >> 6, c = item & 63, b = bh >> 2, h = bh & 3;
    unsigned char* ws = P.ws;
    const float* SA = (const float*)(ws + WS_SA); const float* SR = (const float*)(ws + WS_SR);
    LAS unsigned char* kwt = lds; LAS unsigned char* vt = lds + 128 * T72;
    const int t0 = c * 64;
    if (tid < 256) {
        const int cgp = tid & 15, tg = tid >> 4;
        float o[4][8]; conv_silu4(R.xr, P.in[4], P.in[5], h * 128 + cgp * 8, 1.0f, o);
        bf16* qc = (bf16*)(ws + WS_QC) + mp_off(0, b, h, t0 + 4 * tg) + cgp * 8;
#pragma unroll
        for (int t = 0; t < 4; ++t) { u32x4 w; w.x = pk2(o[t][0], o[t][1]); w.y = pk2(o[t][2], o[t][3]); w.z = pk2(o[t][4], o[t][5]); w.w = pk2(o[t][6], o[t][7]); *(u32x4*)(qc + t * 128) = w; }
    } else {
        const int idx = tid - 256, tg = idx & 15, cgp = idx >> 4;
        const f32x4 av = *(const f32x4*)(SA + bh * SEQ + t0 + 4 * tg); const float rl = SR[bh * SEQ + t0 + 63];
        float o[4][8]; conv_silu4(R.xr, P.in[4], P.in[5], 512 + h * 128 + cgp * 8, 0.08838834764831845f, o);
        bf16* kc = (bf16*)(ws + WS_KC) + mp_off(0, b, h, t0 + 4 * tg) + cgp * 8;
#pragma unroll
        for (int t = 0; t < 4; ++t) { u32x4 w; w.x = pk2(o[t][0], o[t][1]); w.y = pk2(o[t][2], o[t][3]); w.z = pk2(o[t][4], o[t][5]); w.w = pk2(o[t][6], o[t][7]); *(u32x4*)(kc + t * 128) = w; }
        const float w0 = __expf(av[0] - rl), w1 = __expf(av[1] - rl), w2 = __expf(av[2] - rl), w3 = __expf(av[3] - rl);
        LAS unsigned char* d = kwt + (cgp * 8) * T72 + tg * 8;
#pragma unroll
        for (int e = 0; e < 8; ++e) { u32x2 w; w.x = pk2(o[0][e] * w0, o[1][e] * w1); w.y = pk2(o[2][e] * w2, o[3][e] * w3); *(LAS u32x2*)(d + e * T72) = w; }
    }
    { const int eg = tid >> 5, tg = tid & 31; LAS unsigned char* d = vt + (eg * 8) * T72 + tg * 4; const u32x4 va = R.va, vb = R.vb;
      *(LAS unsigned*)(d + 0 * T72) = (va.x & 0xffffu) | (vb.x << 16); *(LAS unsigned*)(d + 1 * T72) = (va.x >> 16) | (vb.x & 0xffff0000u);
      *(LAS unsigned*)(d + 2 * T72) = (va.y & 0xffffu) | (vb.y << 16); *(LAS unsigned*)(d + 3 * T72) = (va.y >> 16) | (vb.y & 0xffff0000u);
      *(LAS unsigned*)(d + 4 * T72) = (va.z & 0xffffu) | (vb.z << 16); *(LAS unsigned*)(d + 5 * T72) = (va.z >> 16) | (vb.z & 0xffff0000u);
      *(LAS unsigned*)(d + 6 * T72) = (va.w & 0xffffu) | (vb.w << 16); *(LAS unsigned*)(d + 7 * T72) = (va.w >> 16) | (vb.w & 0xffff0000u); }
    __syncthreads();
    if (next >= 0) mlstm_local_load(P, next, R);
    const float dcy = first ? 0.f : __expf(((const float*)(ws + WS_SMC))[bh * 64 + c] - SR[bh * SEQ + t0 + 63]);
    if (tid < 128) { float s = 0.f;
#pragma unroll
        for (int q = 0; q < 8; ++q) { const u32x4 w = *(const LAS u32x4*)(kwt + tid * T72 + q * 16); s += (bflo(w.x) + bfhi(w.x)) + (bflo(w.y) + bfhi(w.y)) + (bflo(w.z) + bfhi(w.z)) + (bflo(w.w) + bfhi(w.w)); }
        nrun = dcy * nrun + s;
        ((float*)(ws + WS_NS))[(size_t)item * 128 + tid] = nrun; }
    bf16x8 vf[2];
#pragma unroll
    for (int ks = 0; ks < 2; ++ks) vf[ks] = *(const LAS bf16x8*)(vt + (wave * 16 + fr) * T72 + ks * 64 + g * 16);
    bf16* ST = (bf16*)(ws + WS_BUFB) + (size_t)item * 16384 + (wave * 16 + fr) * 128;
#pragma unroll
    for (int dt = 0; dt < 8; ++dt) { LAS f32x4* sp = (LAS f32x4*)(lds + 40960 + ((wave * 8 + dt) * 64 + lane) * 16);
        f32x4 a = (f32x4){0.f, 0.f, 0.f, 0.f}; if (!first) a = *sp * dcy;
#pragma unroll
        for (int ks = 0; ks < 2; ++ks) { const bf16x8 kf = *(const LAS bf16x8*)(kwt + (dt * 16 + fr) * T72 + ks * 64 + g * 16); a = MFMA16(kf, vf[ks], a); }
        *sp = a;
        u32x2 w; w.x = pk2(a[0], a[1]); w.y = pk2(a[2], a[3]);
        *(u32x2*)(ST + dt * 16 + 4 * g) = w; }
    __syncthreads();
}

__device__ __forceinline__ void mlstm_scan(const Params& P) {
    unsigned char* ws = P.ws; const float* SR = (const float*)(ws + WS_SR); const float* SMC = (const float*)(ws + WS_SMC);
    const int G = gridDim.x;
    for (int gid = blockIdx.x * 512 + threadIdx.x; gid < 32 * 4096; gid += G * 512) {
        const int bh = gid >> 12, e4 = gid & 4095;
        const u32x2* st = (const u32x2*)((const bf16*)(ws + WS_BUFB) + (size_t)bh * 64 * 16384) + e4;
        u32x2* gb = (u32x2*)((bf16*)(ws + WS_G) + (size_t)bh * 8 * 16384) + e4;
        const bool has_n = e4 < 128; const float* ns = (const float*)(ws + WS_NS) + (size_t)bh * 64 * 128 + (has_n ? e4 : 0); float* gn = (float*)(ws + WS_GN) + (size_t)bh * 8 * 128 + (has_n ? e4 : 0);
        u32x2 u[7]; float un[7], D[7];
#pragma unroll
        for (int g = 0; g < 7; ++g) { u[g] = st[(size_t)(8 * g + 7) * 4096]; un[g] = has_n ? ns[(8 * g + 7) * 128] : 0.f; float ld = 0.f;
#pragma unroll
            for (int q = 0; q < 8; ++q) ld += SMC[bh * 64 + 8 * g + q] - SR[bh * SEQ + (8 * g + q) * 64 + 63];
            D[g] = __expf(ld); }
        float s0 = 0.f, s1 = 0.f, s2 = 0.f, s3 = 0.f, sn = 0.f;
#pragma unroll
        for (int g = 0; g < 7; ++g) { s0 = D[g] * s0 + bflo(u[g].x); s1 = D[g] * s1 + bfhi(u[g].x); s2 = D[g] * s2 + bflo(u[g].y); s3 = D[g] * s3 + bfhi(u[g].y);
            u32x2 w; w.x = pk2(s0, s1); w.y = pk2(s2, s3); gb[(size_t)(g + 1) * 4096] = w;
            sn = D[g] * sn + un[g]; if (has_n) gn[(g + 1) * 128] = sn; }
    }
}

constexpr int M_QOFF = 0, M_KOFF = 64 * T136, M_VOFF = 2 * 64 * T136, M_COFF = M_VOFF + 128 * T72, M_NOFF = M_COFF + 128 * T136, M_SOFF = M_NOFF + 512, M_GOFF = 90112, M_GNOFF = M_GOFF + 32768;
struct MBig { u32x4 q[2], k[2], va, vb, c[4]; float nv, eL; };
__device__ __forceinline__ void mlstm_out_load(const Params& P, int item, MBig& R) {
    const int tid = threadIdx.x; const int bh = item >> 6, c = item & 63, b = bh >> 2, h = bh & 3, t0 = c * 64; unsigned char* ws = P.ws;
    const bf16* qc = (const bf16*)(ws + WS_QC) + mp_off(0, b, h, t0); const bf16* kc = (const bf16*)(ws + WS_KC) + mp_off(0, b, h, t0);
#pragma unroll
    for (int i = 0; i < 2; ++i) { const int ch = tid + 512 * i, row = ch >> 4, q = ch & 15; R.q[i] = *(const u32x4*)(qc + row * 128 + q * 8); R.k[i] = *(const u32x4*)(kc + row * 128 + q * 8); }
    { const int eg = tid >> 5, tg = tid & 31; const bf16* s0 = (const bf16*)(ws + WS_MP) + mp_off(2, b, h, t0 + 2 * tg) + eg * 8; R.va = *(const u32x4*)s0; R.vb = *(const u32x4*)(s0 + 128); }
    const int grp = c >> 3, jg = c & 7;
    const bf16* ST = (const bf16*)(ws + WS_BUFB) + (size_t)(item - 1) * 16384;
#pragma unroll
    for (int i = 0; i < 4; ++i) { const int ch = tid + 512 * i, e = ch >> 4, q = ch & 15; R.c[i] = (u32x4){0u, 0u, 0u, 0u};
        if (jg > 0) R.c[i] = *(const u32x4*)(ST + e * 128 + q * 8); }
    R.nv = (jg > 0 && tid < 128) ? ((const float*)(ws + WS_NS))[(size_t)(item - 1) * 128 + tid] : 0.f;
    { const float* SR = (const float*)(ws + WS_SR); const float* SMC = (const float*)(ws + WS_SMC); float ld = 0.f;
      for (int q = 0; q < jg; ++q) ld += SMC[bh * 64 + 8 * grp + q] - SR[bh * SEQ + (8 * grp + q) * 64 + 63];
      R.eL = __expf(ld); }
}
__device__ __forceinline__ void mlstm_out_stage(const MBig& R, LAS unsigned char* lds) {
    const int tid = threadIdx.x;
#pragma unroll
    for (int i = 0; i < 2; ++i) { const int ch = tid + 512 * i, row = ch >> 4, q = ch & 15; *(LAS u32x4*)(lds + M_QOFF + row * T136 + q * 16) = R.q[i]; *(LAS u32x4*)(lds + M_KOFF + row * T136 + q * 16) = R.k[i]; }
    { const int eg = tid >> 5, tg = tid & 31; LAS unsigned char* d = lds + M_VOFF + (eg * 8) * T72 + tg * 4; const u32x4 va = R.va, vb = R.vb;
      *(LAS unsigned*)(d + 0 * T72) = (va.x & 0xffffu) | (vb.x << 16); *(LAS unsigned*)(d + 1 * T72) = (va.x >> 16) | (vb.x & 0xffff0000u);
      *(LAS unsigned*)(d + 2 * T72) = (va.y & 0xffffu) | (vb.y << 16); *(LAS unsigned*)(d + 3 * T72) = (va.y >> 16) | (vb.y & 0xffff0000u);
      *(LAS unsigned*)(d + 4 * T72) = (va.z & 0xffffu) | (vb.z << 16); *(LAS unsigned*)(d + 5 * T72) = (va.z >> 16) | (vb.z & 0xffff0000u);
      *(LAS unsigned*)(d + 6 * T72) = (va.w & 0xffffu) | (vb.w << 16); *(LAS unsigned*)(d + 7 * T72) = (va.w >> 16) | (vb.w & 0xffff0000u); }
    const float eL = R.eL;
#pragma unroll
    for (int i = 0; i < 4; ++i) { const int ch = tid + 512 * i, e = ch >> 4, q = ch & 15; const u32x4 a = R.c[i], gq = *(const LAS u32x4*)(lds + M_GOFF + ch * 16); u32x4 w;
        w.x = pk2(bflo(a.x) + eL * bflo(gq.x), bfhi(a.x) + eL * bfhi(gq.x)); w.y = pk2(bflo(a.y) + eL * bflo(gq.y), bfhi(a.y) + eL * bfhi(gq.y));
        w.z = pk2(bflo(a.z) + eL * bflo(gq.z), bfhi(a.z) + eL * bfhi(gq.z)); w.w = pk2(bflo(a.w) + eL * bflo(gq.w), bfhi(a.w) + eL * bfhi(gq.w));
        *(LAS u32x4*)(lds + M_COFF + e * T136 + q * 16) = w; }
    if (tid < 128) ((LAS float*)(lds + M_NOFF))[tid] = R.nv + eL * ((LAS float*)(lds + M_GNOFF))[tid];
}
__device__ __forceinline__ void mlstm_group_state(const Params& P, int bh, int grp, LAS unsigned char* lds) {
    const int tid = threadIdx.x; unsigned char* ws = P.ws; const float* SR = (const float*)(ws + WS_SR); const float* SMC = (const float*)(ws + WS_SMC);
    LAS float* Dl = (LAS float*)(lds + M_GNOFF + 512);
#pragma unroll 1
    for (int g = 0; g < 7; ++g) { float ld = 0.f; if (g < grp) {
#pragma unroll
            for (int q = 0; q < 8; ++q) ld += SMC[bh * 64 + 8 * g + q] - SR[bh * SEQ + (8 * g + q) * 64 + 63]; }
        if (tid == 0) Dl[g] = __expf(ld); }
    __syncthreads();
    const bf16* ST = (const bf16*)(ws + WS_BUFB) + (size_t)bh * 64 * 16384;
#pragma unroll 1
    for (int i = 0; i < 4; ++i) { const int ch = tid + 512 * i;
        float a[8] = {0.f, 0.f, 0.f, 0.f, 0.f, 0.f, 0.f, 0.f};
#pragma unroll 1
        for (int g0 = 0; g0 < 8; g0 += 4) { u32x4 u[4];
#pragma unroll
            for (int j = 0; j < 4; ++j) { u[j] = (u32x4){0u, 0u, 0u, 0u}; if (g0 + j < grp) u[j] = *(const u32x4*)(ST + (size_t)(8 * (g0 + j) + 7) * 16384 + ch * 8); }
#pragma unroll
            for (int j = 0; j < 4; ++j) if (g0 + j < grp) { const float d = Dl[g0 + j];
                a[0] = d * a[0] + bflo(u[j].x); a[1] = d * a[1] + bfhi(u[j].x); a[2] = d * a[2] + bflo(u[j].y); a[3] = d * a[3] + bfhi(u[j].y);
                a[4] = d * a[4] + bflo(u[j].z); a[5] = d * a[5] + bfhi(u[j].z); a[6] = d * a[6] + bflo(u[j].w); a[7] = d * a[7] + bfhi(u[j].w); } }
        u32x4 w; w.x = pk2(a[0], a[1]); w.y = pk2(a[2], a[3]); w.z = pk2(a[4], a[5]); w.w = pk2(a[6], a[7]);
        *(LAS u32x4*)(lds + M_GOFF + ch * 16) = w; }
    if (tid < 128) { const float* ns = (const float*)(ws + WS_NS) + (size_t)bh * 64 * 128 + tid; float un[7], sn = 0.f;
#pragma unroll
        for (int g = 0; g < 7; ++g) un[g] = (g < grp) ? ns[(8 * g + 7) * 128] : 0.f;
#pragma unroll
        for (int g = 0; g < 7; ++g) if (g < grp) sn = Dl[g] * sn + un[g];
        ((LAS float*)(lds + M_GNOFF))[tid] = sn; }
}
__device__ __forceinline__ void mlstm_out_item(const Params& P, int item, int next, MBig& R, LAS unsigned char* lds) {
    const int tid = threadIdx.x, lane = tid & 63, wave = tid >> 6, fr = lane & 15, g = lane >> 4;
    const int bh = item >> 6, c = item & 63, b = bh >> 2, h = bh & 3, t0 = c * 64;
    unsigned char* ws = P.ws; const bf16* proj = (const bf16*)(ws + WS_MP);
    const float* SA = (const float*)(ws + WS_SA); const float* SR = (const float*)(ws + WS_SR); const float* SB = (const float*)(ws + WS_SB); const float* SMC = (const float*)(ws + WS_SMC);
    if ((c & 7) == 0) mlstm_group_state(P, bh, c >> 3, lds);
    const int tt = wave & 3, eh = wave >> 2, tq = tt * 16 + fr;
    const float r_t = SR[bh * SEQ + t0 + tq], b_t = SB[bh * SEQ + t0 + tq], mc = SMC[bh * 64 + c];
    f32x4 avs[4]; u32x2 mos[4]; f32x4 gns[4];
#pragma unroll
    for (int st = 0; st < 4; ++st) avs[st] = *(const f32x4*)(SA + bh * SEQ + t0 + st * 16 + 4 * g);
#pragma unroll
    for (int et = 0; et < 4; ++et) { const int e = eh * 64 + et * 16 + 4 * g; mos[et] = *(const u32x2*)(proj + mp_off(3, b, h, t0 + tq) + e); gns[et] = *(const f32x4*)(P.in[7] + h * 128 + e); }
    mlstm_out_stage(R, lds);
    __syncthreads();
    if (next >= 0) mlstm_out_load(P, next, R);
    bf16x8 qf[4];
#pragma unroll
    for (int ks = 0; ks < 4; ++ks) qf[ks] = *(const LAS bf16x8*)(lds + M_QOFF + tq * T136 + ks * 64 + g * 16);
    float pv[4][4]; float rsum = 0.f;
#pragma unroll
    for (int st = 0; st < 4; ++st) {
        if (st <= tt) { f32x4 a = (f32x4){0.f, 0.f, 0.f, 0.f};
#pragma unroll
            for (int ks = 0; ks < 4; ++ks) { const bf16x8 kf = *(const LAS bf16x8*)(lds + M_KOFF + (st * 16 + fr) * T136 + ks * 64 + g * 16); a = MFMA16(kf, qf[ks], a); }
            const f32x4 av = avs[st];
#pragma unroll
            for (int i = 0; i < 4; ++i) { const int s = st * 16 + 4 * g + i; const float p = (s <= tq) ? a[i] * __expf(av[i] - r_t) : 0.f; pv[st][i] = p; rsum += p; }
        } else {
#pragma unroll
            for (int i = 0; i < 4; ++i) pv[st][i] = 0.f; }
    }
    rsum += __shfl_xor(rsum, 16); rsum += __shfl_xor(rsum, 32);
    float qn = 0.f;
#pragma unroll
    for (int q = 0; q < 4; ++q) { const u32x4 w = *(const LAS u32x4*)(lds + M_QOFF + tq * T136 + g * 64 + q * 16);
        const f32x4 n0 = *(const LAS f32x4*)(lds + M_NOFF + (g * 32 + q * 8) * 4), n1 = *(const LAS f32x4*)(lds + M_NOFF + (g * 32 + q * 8 + 4) * 4);
        qn += (bflo(w.x) * n0[0] + bfhi(w.x) * n0[1]) + (bflo(w.y) * n0[2] + bfhi(w.y) * n0[3]) + (bflo(w.z) * n1[0] + bfhi(w.z) * n1[1]) + (bflo(w.w) * n1[2] + bfhi(w.w) * n1[3]); }
    qn += __shfl_xor(qn, 16); qn += __shfl_xor(qn, 32);
    const float w_inter = __expf(mc - r_t);
    const float den = w_inter * qn + rsum;
    const float idn = 1.0f / fmaxf(fabsf(den), __expf(-(b_t + r_t)));
    bf16x8 pf[2];
#pragma unroll
    for (int ks = 0; ks < 2; ++ks) { u32x4 w; w.x = pk2(pv[2 * ks][0], pv[2 * ks][1]); w.y = pk2(pv[2 * ks][2], pv[2 * ks][3]); w.z = pk2(pv[2 * ks + 1][0], pv[2 * ks + 1][1]); w.w = pk2(pv[2 * ks + 1][2], pv[2 * ks + 1][3]);
        pf[ks] = __builtin_bit_cast(bf16x8, w); }
    float hv[4][4]; float ssq = 0.f;
#pragma unroll
    for (int et = 0; et < 4; ++et) { const int e0 = eh * 64 + et * 16;
        f32x4 ag = (f32x4){0.f, 0.f, 0.f, 0.f}, ap = ag;
#pragma unroll
        for (int ks = 0; ks < 4; ++ks) { const bf16x8 cf = *(const LAS bf16x8*)(lds + M_COFF + (e0 + fr) * T136 + ks * 64 + g * 16); ag = MFMA16(cf, qf[ks], ag); }
#pragma unroll
        for (int ks = 0; ks < 2; ++ks) { const LAS unsigned char* vp = lds + M_VOFF + (e0 + fr) * T72 + (32 * ks + 4 * g) * 2;
            const u32x2 v0 = *(const LAS u32x2*)vp, v1 = *(const LAS u32x2*)(vp + 32); const u32x4 vw = (u32x4){v0.x, v0.y, v1.x, v1.y};
            ap = MFMA16(__builtin_bit_cast(bf16x8, vw), pf[ks], ap); }
#pragma unroll
        for (int i = 0; i < 4; ++i) { const float hh = (w_inter * ag[i] + ap[i]) * idn; hv[et][i] = hh; ssq += hh * hh; } }
    ssq += __shfl_xor(ssq, 16); ssq += __shfl_xor(ssq, 32);
    if (g == 0) ((LAS float*)(lds + M_SOFF))[tq * 2 + eh] = ssq;
    __syncthreads();
    const float tot = ((LAS float*)(lds + M_SOFF))[tq * 2] + ((LAS float*)(lds + M_SOFF))[tq * 2 + 1];
    const float rn = 1.0f / sqrtf(tot * (1.0f / 128.0f) + 1e-6f);
    const size_t tok = (size_t)b * SEQ + t0 + tq;
    bf16* mix = (bf16*)(ws + WS_MIX) + tok * DM + 512 + h * 128;
#pragma unroll
    for (int et = 0; et < 4; ++et) { const int e = eh * 64 + et * 16 + 4 * g;
        const u32x2 mo = mos[et]; const f32x4 gv = gns[et];
        const float m0 = bflo(mo.x), m1 = bfhi(mo.x), m2 = bflo(mo.y), m3 = bfhi(mo.y);
        const float y0 = hv[et][0] * rn * gv[0] * __builtin_amdgcn_rcpf(1.0f + __expf(-m0)), y1 = hv[et][1] * rn * gv[1] * __builtin_amdgcn_rcpf(1.0f + __expf(-m1));
        const float y2 = hv[et][2] * rn * gv[2] * __builtin_amdgcn_rcpf(1.0f + __expf(-m2)), y3 = hv[et][3] * rn * gv[3] * __builtin_amdgcn_rcpf(1.0f + __expf(-m3));
        u32x2 w; w.x = pk2(y0, y1); w.y = pk2(y2, y3); *(u32x2*)(mix + e) = w; }
    __syncthreads();
}

__device__ __forceinline__ void stage_conv_w(const Params& P, int h, bool kpart, LAS float* wl) {
    const int tid = threadIdx.x; const float* cw = P.in[4]; const float* cb = P.in[5]; const int ch0 = (kpart ? 512 : 0) + h * 128;
    for (int i = tid; i < 640; i += 512) { const int j = i >> 7, ch = i & 127; wl[i] = (j < 4) ? cw[j * 1024 + ch0 + ch] : cb[ch0 + ch]; }
}
__device__ __forceinline__ void conv_silu4_lds(const u32x4 (&xr)[7], const LAS float* wl, int ch, float scale, float (&o)[4][8]) {
    float wv[5][8];
#pragma unroll
    for (int j = 0; j < 5; ++j) { const f32x4 a = *(const LAS f32x4*)(wl + j * 128 + ch), c = *(const LAS f32x4*)(wl + j * 128 + ch + 4);
        wv[j][0] = a[0]; wv[j][1] = a[1]; wv[j][2] = a[2]; wv[j][3] = a[3]; wv[j][4] = c[0]; wv[j][5] = c[1]; wv[j][6] = c[2]; wv[j][7] = c[3]; }
    float xv[7][8];
#pragma unroll
    for (int i = 0; i < 7; ++i) { xv[i][0] = bflo(xr[i].x); xv[i][1] = bfhi(xr[i].x); xv[i][2] = bflo(xr[i].y); xv[i][3] = bfhi(xr[i].y); xv[i][4] = bflo(xr[i].z); xv[i][5] = bfhi(xr[i].z); xv[i][6] = bflo(xr[i].w); xv[i][7] = bfhi(xr[i].w); }
#pragma unroll
    for (int t = 0; t < 4; ++t)
#pragma unroll
        for (int e = 0; e < 8; ++e) { float a = wv[4][e];
#pragma unroll
            for (int j = 0; j < 4; ++j) a += wv[j][e] * xv[t + j][e];
            o[t][e] = a * __builtin_amdgcn_rcpf(1.0f + __expf(-a)) * scale; }
}
constexpr int F_KWOFF = 90112, F_DOFF = F_KWOFF + 128 * T72, F_WOFF = F_DOFF + 64;
struct FBig { u32x4 xr[7], va, vb; };
__device__ __forceinline__ void fused_load(const Params& P, int item, bool with_q, FBig& R) {
    const int tid = threadIdx.x; const int bh = item >> 6, c = item & 63, b = bh >> 2, h = bh & 3, t0 = c * 64; const bf16* proj = (const bf16*)(P.ws + WS_MP);
    if (tid < 256) { if (with_q) { const int cgp = tid & 15, tg = tid >> 4; load7(proj, 0, b, h, t0 + 4 * tg, cgp * 8, R.xr); } }
    else { const int idx = tid - 256, tg = idx & 15, cgp = idx >> 4; load7(proj, 1, b, h, t0 + 4 * tg, cgp * 8, R.xr); }
    { const int eg = tid >> 5, tg = tid & 31; const bf16* s0 = proj + mp_off(2, b, h, t0 + 2 * tg) + eg * 8; R.va = *(const u32x4*)s0; R.vb = *(const u32x4*)(s0 + 128); }
}
__device__ __forceinline__ void stage_vt_regs(const u32x4 va, const u32x4 vb, LAS unsigned char* vt) {
    const int tid = threadIdx.x, eg = tid >> 5, tg = tid & 31; LAS unsigned char* d = vt + (eg * 8) * T72 + tg * 4;
    *(LAS unsigned*)(d + 0 * T72) = (va.x & 0xffffu) | (vb.x << 16); *(LAS unsigned*)(d + 1 * T72) = (va.x >> 16) | (vb.x & 0xffff0000u);
    *(LAS unsigned*)(d + 2 * T72) = (va.y & 0xffffu) | (vb.y << 16); *(LAS unsigned*)(d + 3 * T72) = (va.y >> 16) | (vb.y & 0xffff0000u);
    *(LAS unsigned*)(d + 4 * T72) = (va.z & 0xffffu) | (vb.z << 16); *(LAS unsigned*)(d + 5 * T72) = (va.z >> 16) | (vb.z & 0xffff0000u);
    *(LAS unsigned*)(d + 6 * T72) = (va.w & 0xffffu) | (vb.w << 16); *(LAS unsigned*)(d + 7 * T72) = (va.w >> 16) | (vb.w & 0xffff0000u);
}
__device__ __forceinline__ void k_conv_stage(const Params& P, const FBig& R, int bh, int h, int t0, const LAS float* wk, LAS unsigned char* kwt, LAS unsigned char* knat) {
    const int idx = threadIdx.x - 256, tg = idx & 15, cgp = idx >> 4; const float* SA = (const float*)(P.ws + WS_SA); const float* SR = (const float*)(P.ws + WS_SR);
    const f32x4 av = *(const f32x4*)(SA + bh * SEQ + t0 + 4 * tg); const float rl = SR[bh * SEQ + t0 + 63];
    float o[4][8]; conv_silu4_lds(R.xr, wk, cgp * 8, 0.08838834764831845f, o);
    if (knat) {
#pragma unroll
        for (int t = 0; t < 4; ++t) { u32x4 w; w.x = pk2(o[t][0], o[t][1]); w.y = pk2(o[t][2], o[t][3]); w.z = pk2(o[t][4], o[t][5]); w.w = pk2(o[t][6], o[t][7]); *(LAS u32x4*)(knat + (4 * tg + t) * T136 + cgp * 16) = w; } }
    const float w0 = __expf(av[0] - rl), w1 = __expf(av[1] - rl), w2 = __expf(av[2] - rl), w3 = __expf(av[3] - rl);
    LAS unsigned char* d = kwt + (cgp * 8) * T72 + tg * 8;
#pragma unroll
    for (int e = 0; e < 8; ++e) { u32x2 w; w.x = pk2(o[0][e] * w0, o[1][e] * w1); w.y = pk2(o[2][e] * w2, o[3][e] * w3); *(LAS u32x2*)(d + e * T72) = w; }
}
__device__ __forceinline__ void mlstm_state_item(const Params& P, int item, int next, bool first, bool last, float& nrun, FBig& R, LAS unsigned char* lds) {
    const int tid = threadIdx.x, lane = tid & 63, wave = tid >> 6, fr = lane & 15, g = lane >> 4;
    const int bh = item >> 6, c = item & 63, h = bh & 3, t0 = c * 64; unsigned char* ws = P.ws; const float* SR = (const float*)(ws + WS_SR);
    LAS unsigned char* kwt = lds; LAS unsigned char* vt = lds + 128 * T72; LAS float* wk = (LAS float*)(lds + 106496);
    if (first) { stage_conv_w(P, h, true, wk); __syncthreads(); }
    if (tid >= 256) k_conv_stage(P, R, bh, h, t0, wk, kwt, nullptr);
    stage_vt_regs(R.va, R.vb, vt);
    __syncthreads();
    if (next >= 0) fused_load(P, next, false, R);
    const float dcy = first ? 0.f : __expf(((const float*)(ws + WS_SMC))[bh * 64 + c] - SR[bh * SEQ + t0 + 63]);
    if (tid < 128) { float s = 0.f;
#pragma unroll
        for (int q = 0; q < 8; ++q) { const u32x4 w = *(const LAS u32x4*)(kwt + tid * T72 + q * 16); s += (bflo(w.x) + bfhi(w.x)) + (bflo(w.y) + bfhi(w.y)) + (bflo(w.z) + bfhi(w.z)) + (bflo(w.w) + bfhi(w.w)); }
        nrun = dcy * nrun + s;
        if (last) ((float*)(ws + WS_NS))[(size_t)item * 128 + tid] = nrun; }
    bf16x8 vf[2];
#pragma unroll
    for (int ks = 0; ks < 2; ++ks) vf[ks] = *(const LAS bf16x8*)(vt + (wave * 16 + fr) * T72 + ks * 64 + g * 16);
    bf16* ST = (bf16*)(ws + WS_BUFB) + (size_t)item * 16384 + (wave * 16 + fr) * 128;
#pragma unroll
    for (int dt = 0; dt < 8; ++dt) { LAS f32x4* sp = (LAS f32x4*)(lds + 40960 + ((wave * 8 + dt) * 64 + lane) * 16);
        f32x4 a = (f32x4){0.f, 0.f, 0.f, 0.f}; if (!first) a = *sp * dcy;
#pragma unroll
        for (int ks = 0; ks < 2; ++ks) { const bf16x8 kf = *(const LAS bf16x8*)(kwt + (dt * 16 + fr) * T72 + ks * 64 + g * 16); a = MFMA16(kf, vf[ks], a); }
        *sp = a;
        if (last) { u32x2 w; w.x = pk2(a[0], a[1]); w.y = pk2(a[2], a[3]); *(u32x2*)(ST + dt * 16 + 4 * g) = w; } }
    __syncthreads();
}
__device__ __forceinline__ void fused_group_start(const Params& P, int bh, int grp, float& nrun, LAS unsigned char* lds) {
    f32x4 st[8];
    const int tid = threadIdx.x, lane = tid & 63, wave = tid >> 6, fr = lane & 15, g = lane >> 4; unsigned char* ws = P.ws;
    const float* SR = (const float*)(ws + WS_SR); const float* SMC = (const float*)(ws + WS_SMC);
    LAS float* Dl = (LAS float*)(lds + F_DOFF);
    stage_conv_w(P, bh & 3, false, (LAS float*)(lds + F_WOFF)); stage_conv_w(P, bh & 3, true, (LAS float*)(lds + F_WOFF) + 640);
#pragma unroll 1
    for (int gg = 0; gg < 7; ++gg) { float ld = 0.f; if (gg < grp) {
#pragma unroll
            for (int q = 0; q < 8; ++q) ld += SMC[bh * 64 + 8 * gg + q] - SR[bh * SEQ + (8 * gg + q) * 64 + 63]; }
        if (tid == 0) Dl[gg] = __expf(ld); }
    __syncthreads();
    const bf16* ST = (const bf16*)(ws + WS_BUFB) + (size_t)bh * 64 * 16384 + (wave * 16 + fr) * 128 + 4 * g;
#pragma unroll
    for (int dt = 0; dt < 8; ++dt) st[dt] = (f32x4){0.f, 0.f, 0.f, 0.f};
#pragma unroll 1
    for (int gg = 0; gg < grp; ++gg) { const float d = Dl[gg]; u32x2 u[8];
#pragma unroll
        for (int dt = 0; dt < 8; ++dt) u[dt] = *(const u32x2*)(ST + (size_t)(8 * gg + 7) * 16384 + dt * 16);
#pragma unroll
        for (int dt = 0; dt < 8; ++dt) { st[dt][0] = d * st[dt][0] + bflo(u[dt].x); st[dt][1] = d * st[dt][1] + bfhi(u[dt].x); st[dt][2] = d * st[dt][2] + bflo(u[dt].y); st[dt][3] = d * st[dt][3] + bfhi(u[dt].y); } }
#pragma unroll
    for (int dt = 0; dt < 8; ++dt) { u32x2 w; w.x = pk2(st[dt][0], st[dt][1]); w.y = pk2(st[dt][2], st[dt][3]); *(LAS u32x2*)(lds + M_COFF + (wave * 16 + fr) * T136 + (dt * 16 + 4 * g) * 2) = w; }
    if (tid < 128) { const float* ns = (const float*)(ws + WS_NS) + (size_t)bh * 64 * 128 + tid; float sn = 0.f;
#pragma unroll 1
        for (int gg = 0; gg < grp; ++gg) sn = Dl[gg] * sn + ns[(8 * gg + 7) * 128];
        nrun = sn; ((LAS float*)(lds + M_NOFF))[tid] = sn; }
}
__device__ __forceinline__ void mlstm_fused_item(const Params& P, int item, int next, float& nrun, FBig& R, LAS unsigned char* lds) {
    const int tid = threadIdx.x, lane = tid & 63, wave = tid >> 6, fr = lane & 15, g = lane >> 4;
    const int bh = item >> 6, c = item & 63, b = bh >> 2, h = bh & 3, t0 = c * 64;
    unsigned char* ws = P.ws; const bf16* proj = (const bf16*)(ws + WS_MP);
    const float* SA = (const float*)(ws + WS_SA); const float* SR = (const float*)(ws + WS_SR); const float* SB = (const float*)(ws + WS_SB); const float* SMC = (const float*)(ws + WS_SMC);
    if ((c & 7) == 0) fused_group_start(P, bh, c >> 3, nrun, lds);
    const int tt = wave & 3, eh = wave >> 2, tq = tt * 16 + fr;
    const float r_t = SR[bh * SEQ + t0 + tq], b_t = SB[bh * SEQ + t0 + tq], mc = SMC[bh * 64 + c];
    f32x4 avs[4];
#pragma unroll
    for (int st = 0; st < 4; ++st) avs[st] = *(const f32x4*)(SA + bh * SEQ + t0 + st * 16 + 4 * g);
    if (tid < 256) { const int cgp = tid & 15, tg = tid >> 4; float o[4][8]; conv_silu4_lds(R.xr, (const LAS float*)(lds + F_WOFF), cgp * 8, 1.0f, o);
#pragma unroll
        for (int t = 0; t < 4; ++t) { u32x4 w; w.x = pk2(o[t][0], o[t][1]); w.y = pk2(o[t][2], o[t][3]); w.z = pk2(o[t][4], o[t][5]); w.w = pk2(o[t][6], o[t][7]); *(LAS u32x4*)(lds + M_QOFF + (4 * tg + t) * T136 + cgp * 16) = w; } }
    else k_conv_stage(P, R, bh, h, t0, (const LAS float*)(lds + F_WOFF) + 640, lds + F_KWOFF, lds + M_KOFF);
    stage_vt_regs(R.va, R.vb, lds + M_VOFF);
    __syncthreads();
    if (next >= 0) fused_load(P, next, true, R);
    bf16x8 qf[4];
#pragma unroll
    for (int ks = 0; ks < 4; ++ks) qf[ks] = *(const LAS bf16x8*)(lds + M_QOFF + tq * T136 + ks * 64 + g * 16);
    float pv[4][4]; float rsum = 0.f;
#pragma unroll
    for (int st = 0; st < 4; ++st) {
        if (st <= tt) { f32x4 a = (f32x4){0.f, 0.f, 0.f, 0.f};
#pragma unroll
            for (int ks = 0; ks < 4; ++ks) { const bf16x8 kf = *(const LAS bf16x8*)(lds + M_KOFF + (st * 16 + fr) * T136 + ks * 64 + g * 16); a = MFMA16(kf, qf[ks], a); }
            const f32x4 av = avs[st];
#pragma unroll
            for (int i = 0; i < 4; ++i) { const int s = st * 16 + 4 * g + i; const float p = (s <= tq) ? a[i] * __expf(av[i] - r_t) : 0.f; pv[st][i] = p; rsum += p; }
        } else {
#pragma unroll
            for (int i = 0; i < 4; ++i) pv[st][i] = 0.f; }
    }
    rsum += __shfl_xor(rsum, 16); rsum += __shfl_xor(rsum, 32);
    float qn = 0.f;
#pragma unroll
    for (int q = 0; q < 4; ++q) { const u32x4 w = *(const LAS u32x4*)(lds + M_QOFF + tq * T136 + g * 64 + q * 16);
        const f32x4 n0 = *(const LAS f32x4*)(lds + M_NOFF + (g * 32 + q * 8) * 4), n1 = *(const LAS f32x4*)(lds + M_NOFF + (g * 32 + q * 8 + 4) * 4);
        qn += (bflo(w.x) * n0[0] + bfhi(w.x) * n0[1]) + (bflo(w.y) * n0[2] + bfhi(w.y) * n0[3]) + (bflo(w.z) * n1[0] + bfhi(w.z) * n1[1]) + (bflo(w.w) * n1[2] + bfhi(w.w) * n1[3]); }
    qn += __shfl_xor(qn, 16); qn += __shfl_xor(qn, 32);
    const float w_inter = __expf(mc - r_t);
    const float den = w_inter * qn + rsum;
    const float idn = 1.0f / fmaxf(fabsf(den), __expf(-(b_t + r_t)));
    bf16x8 pf[2];
#pragma unroll
    for (int ks = 0; ks < 2; ++ks) { u32x4 w; w.x = pk2(pv[2 * ks][0], pv[2 * ks][1]); w.y = pk2(pv[2 * ks][2], pv[2 * ks][3]); w.z = pk2(pv[2 * ks + 1][0], pv[2 * ks + 1][1]); w.w = pk2(pv[2 * ks + 1][2], pv[2 * ks + 1][3]);
        pf[ks] = __builtin_bit_cast(bf16x8, w); }
    u32x2 mos[4]; f32x4 gns[4];
#pragma unroll
    for (int et = 0; et < 4; ++et) { const int e = eh * 64 + et * 16 + 4 * g; mos[et] = *(const u32x2*)(proj + mp_off(3, b, h, t0 + tq) + e); gns[et] = *(const f32x4*)(P.in[7] + h * 128 + e); }
    float hv[4][4]; float ssq = 0.f;
#pragma unroll
    for (int et = 0; et < 4; ++et) { const int e0 = eh * 64 + et * 16;
        f32x4 ag = (f32x4){0.f, 0.f, 0.f, 0.f}, ap = ag;
#pragma unroll
        for (int ks = 0; ks < 4; ++ks) { const bf16x8 cf = *(const LAS bf16x8*)(lds + M_COFF + (e0 + fr) * T136 + ks * 64 + g * 16); ag = MFMA16(cf, qf[ks], ag); }
#pragma unroll
        for (int ks = 0; ks < 2; ++ks) { const LAS unsigned char* vp = lds + M_VOFF + (e0 + fr) * T72 + (32 * ks + 4 * g) * 2;
            const u32x2 v0 = *(const LAS u32x2*)vp, v1 = *(const LAS u32x2*)(vp + 32); const u32x4 vw = (u32x4){v0.x, v0.y, v1.x, v1.y};
            ap = MFMA16(__builtin_bit_cast(bf16x8, vw), pf[ks], ap); }
#pragma unroll
        for (int i = 0; i < 4; ++i) { const float hh = (w_inter * ag[i] + ap[i]) * idn; hv[et][i] = hh; ssq += hh * hh; } }
    ssq += __shfl_xor(ssq, 16); ssq += __shfl_xor(ssq, 32);
    if (g == 0) ((LAS float*)(lds + M_SOFF))[tq * 2 + eh] = ssq;
    __syncthreads();
    const float tot = ((LAS float*)(lds + M_SOFF))[tq * 2] + ((LAS float*)(lds + M_SOFF))[tq * 2 + 1];
    const float rn = 1.0f / sqrtf(tot * (1.0f / 128.0f) + 1e-6f);
    const size_t tok = (size_t)b * SEQ + t0 + tq;
    bf16* mix = (bf16*)(ws + WS_MIX) + tok * DM + 512 + h * 128;
#pragma unroll
    for (int et = 0; et < 4; ++et) { const int e = eh * 64 + et * 16 + 4 * g;
        const u32x2 mo = mos[et]; const f32x4 gv = gns[et];
        const float m0 = bflo(mo.x), m1 = bfhi(mo.x), m2 = bflo(mo.y), m3 = bfhi(mo.y);
        const float y0 = hv[et][0] * rn * gv[0] * __builtin_amdgcn_rcpf(1.0f + __expf(-m0)), y1 = hv[et][1] * rn * gv[1] * __builtin_amdgcn_rcpf(1.0f + __expf(-m1));
        const float y2 = hv[et][2] * rn * gv[2] * __builtin_amdgcn_rcpf(1.0f + __expf(-m2)), y3 = hv[et][3] * rn * gv[3] * __builtin_amdgcn_rcpf(1.0f + __expf(-m3));
        u32x2 w; w.x = pk2(y0, y1); w.y = pk2(y2, y3); *(u32x2*)(mix + e) = w; }
    { const float dcy = __expf(mc - SR[bh * SEQ + t0 + 63]);
      LAS unsigned char* kwt = lds + F_KWOFF; LAS unsigned char* vt = lds + M_VOFF;
      if (tid < 128) { float s = 0.f;
#pragma unroll
          for (int q = 0; q < 8; ++q) { const u32x4 w = *(const LAS u32x4*)(kwt + tid * T72 + q * 16); s += (bflo(w.x) + bfhi(w.x)) + (bflo(w.y) + bfhi(w.y)) + (bflo(w.z) + bfhi(w.z)) + (bflo(w.w) + bfhi(w.w)); }
          nrun = dcy * nrun + s; ((LAS float*)(lds + M_NOFF))[tid] = nrun; }
      bf16x8 vf[2];
#pragma unroll
      for (int ks = 0; ks < 2; ++ks) vf[ks] = *(const LAS bf16x8*)(vt + (wave * 16 + fr) * T72 + ks * 64 + g * 16);
#pragma unroll
      for (int dt = 0; dt < 8; ++dt) { LAS u32x2* cp = (LAS u32x2*)(lds + M_COFF + (wave * 16 + fr) * T136 + (dt * 16 + 4 * g) * 2);
          const u32x2 cw = *cp; f32x4 a = (f32x4){bflo(cw.x), bfhi(cw.x), bflo(cw.y), bfhi(cw.y)} * dcy;
#pragma unroll
          for (int ks = 0; ks < 2; ++ks) { const bf16x8 kf = *(const LAS bf16x8*)(kwt + (dt * 16 + fr) * T72 + ks * 64 + g * 16); a = MFMA16(kf, vf[ks], a); }
          u32x2 w; w.x = pk2(a[0], a[1]); w.y = pk2(a[2], a[3]); *cp = w; } }
    __syncthreads();
}

__device__ __forceinline__ void attn_combine(const Params& P) {
    unsigned char* ws = P.ws; const bf16* OP = (const bf16*)(ws + WS_OP); const float* LSE = (const float*)(ws + WS_LSE); bf16* mix = (bf16*)(ws + WS_MIX);
    const int G = gridDim.x;
    for (int idx0 = blockIdx.x * 512 + threadIdx.x; idx0 < MT * 64; idx0 += G * 512 * 4) {
        float l[4][3]; u32x4 v[4][3];
#pragma unroll
        for (int q = 0; q < 4; ++q) { const int idx = idx0 + q * G * 512; if (idx < MT * 64) { const int tok = idx >> 6, cc = idx & 63, h = cc >> 3;
#pragma unroll
            for (int p = 0; p < 3; ++p) { l[q][p] = LSE[(size_t)p * MT * 8 + (size_t)tok * 8 + h]; v[q][p] = *(const u32x4*)(OP + (size_t)p * MT * 512 + (size_t)tok * 512 + cc * 8); } } }
#pragma unroll
        for (int q = 0; q < 4; ++q) { const int idx = idx0 + q * G * 512; if (idx < MT * 64) { const int tok = idx >> 6, cc = idx & 63;
            const float mx = fmaxf(l[q][0], fmaxf(l[q][1], l[q][2])); float w0 = __expf(l[q][0] - mx), w1 = __expf(l[q][1] - mx), w2 = __expf(l[q][2] - mx); const float iw = __builtin_amdgcn_rcpf(w0 + w1 + w2); w0 *= iw; w1 *= iw; w2 *= iw;
            const u32x4 a = v[q][0], bq = v[q][1], cq = v[q][2]; u32x4 o;
            o.x = pk2(w0 * bflo(a.x) + w1 * bflo(bq.x) + w2 * bflo(cq.x), w0 * bfhi(a.x) + w1 * bfhi(bq.x) + w2 * bfhi(cq.x));
            o.y = pk2(w0 * bflo(a.y) + w1 * bflo(bq.y) + w2 * bflo(cq.y), w0 * bfhi(a.y) + w1 * bfhi(bq.y) + w2 * bfhi(cq.y));
            o.z = pk2(w0 * bflo(a.z) + w1 * bflo(bq.z) + w2 * bflo(cq.z), w0 * bfhi(a.z) + w1 * bfhi(bq.z) + w2 * bfhi(cq.z));
            o.w = pk2(w0 * bflo(a.w) + w1 * bflo(bq.w) + w2 * bflo(cq.w), w0 * bfhi(a.w) + w1 * bfhi(bq.w) + w2 * bfhi(cq.w));
            *(u32x4*)(mix + (size_t)tok * DM + cc * 8) = o; } }
    }
}

__device__ __forceinline__ void final_norm(const Params& P) {
    const int lane = threadIdx.x & 63, wave = threadIdx.x >> 6, G = gridDim.x; const float* SSQ = (const float*)(P.ws + WS_SSQ3); const float* gf = P.in[15];
    const bf16* H3 = (const bf16*)(P.ws + WS_BUFB);
    f32x4 gv[4];
#pragma unroll
    for (int j = 0; j < 2; ++j) { gv[2 * j] = *(const f32x4*)(gf + j * 512 + lane * 8); gv[2 * j + 1] = *(const f32x4*)(gf + j * 512 + lane * 8 + 4); }
    for (int row0 = (blockIdx.x * 8 + wave) * 4; row0 < MT; row0 += G * 32) {
        u32x4 v[4][2]; float rs[4];
#pragma unroll
        for (int r = 0; r < 4; ++r) { rs[r] = pg8::row_rs(SSQ, row0 + r);
#pragma unroll
            for (int j = 0; j < 2; ++j) v[r][j] = *(const u32x4*)(H3 + (size_t)(row0 + r) * DM + j * 512 + lane * 8); }
#pragma unroll
        for (int r = 0; r < 4; ++r) { float* o = P.out + (size_t)(row0 + r) * DM;
#pragma unroll
            for (int j = 0; j < 2; ++j) { const u32x4 w = v[r][j];
                *(f32x4*)(o + j * 512 + lane * 8) = (f32x4){bflo(w.x), bfhi(w.x), bflo(w.y), bfhi(w.y)} * rs[r] * gv[2 * j];
                *(f32x4*)(o + j * 512 + lane * 8 + 4) = (f32x4){bflo(w.z), bfhi(w.z), bflo(w.w), bfhi(w.w)} * rs[r] * gv[2 * j + 1]; } }
    }
}

__global__ void __launch_bounds__(512, 2) hymba_fwd(Params P) {
    extern __shared__ __attribute__((aligned(16))) unsigned char lds_raw[];
    LAS unsigned char* lds = (LAS unsigned char*)lds_raw;
    unsigned char* ws = P.ws; const int G = gridDim.x, bx = blockIdx.x;
    const int lo = P.ph_lo, hi = P.ph_hi;
#define IN(k) (lo <= (k) && (k) < hi)
    if (threadIdx.x < 2) ((volatile LAS unsigned*)(lds + LDS_BAR_OFF))[threadIdx.x] = 0u;
    __syncthreads();
    XcdBarrier bar; bar.bar = (unsigned*)(ws + WS_CTL); bar.x = 0; bar.st = nullptr;
    if (hi - lo > 1) bar = xcd_barrier_post((unsigned*)(ws + WS_CTL), (volatile LAS unsigned*)(lds + LDS_BAR_OFF));
    if (hi == 1000) cg::this_grid().sync();
#define SEAM(k) do { if (IN(k) && IN((k) + 1)) { xcd_barrier(bar); } } while (0)
    if (IN(0)) { p0_prologue(P, lds); }
#if REP_PHASE == 0
    __syncthreads(); p0_prologue(P, lds);
#endif
    SEAM(0);
    if (IN(1)) {
        if (bx < 32) gate_scan(P, bx, lds);
        pg8::Gemm gm{(const pg8::bf16_t*)(ws + WS_BUFA), (const pg8::bf16_t*)(ws + WS_WIN), MT, NPROJ, DM}; pg8::StaticOrder S; S.init(MT, NPROJ, G, bx);
        pg8::EpiProj E{(pg8::bf16_t*)(ws + WS_QKV), (pg8::bf16_t*)(ws + WS_MP), (const float*)(ws + WS_ROPE), (const float*)(ws + WS_ROPE) + 4096 * 8};
        pg8::gemm_phase_sp<pg8::EpiProj, pg8::StaticOrder, true, true>(lds, gm, S, E);
#if REP_PHASE == 1
        __syncthreads(); pg8::gemm_phase_sp<pg8::EpiProj, pg8::StaticOrder, true, true>(lds, gm, S, E);
#endif
    }
    SEAM(1);
    if (IN(2)) {
        { FBig R; float nrun = 0.f;
          if (bx < 256) fused_load(P, bx * 8, false, R);
          for (int gi = bx; gi < 256; gi += G)
              for (int i = 0; i < 8; ++i) { const int it = gi * 8 + i; const int nx = (i < 7) ? it + 1 : ((gi + G < 256) ? (gi + G) * 8 : -1);
                  mlstm_state_item(P, it, nx, i == 0, i == 7, nrun, R, lds); } }
        attn_phase(P, lds);
    #if REP_PHASE == 2
        __syncthreads();
        { FBig R; float nrun = 0.f;
          if (bx < 256) fused_load(P, bx * 8, false, R);
          for (int gi = bx; gi < 256; gi += G)
              for (int i = 0; i < 8; ++i) { const int it = gi * 8 + i; const int nx = (i < 7) ? it + 1 : ((gi + G < 256) ? (gi + G) * 8 : -1);
                  mlstm_state_item(P, it, nx, i == 0, i == 7, nrun, R, lds); } }
        attn_phase(P, lds);
    #endif
    }
    SEAM(2);
#if REP_PHASE == 3
    __syncthreads(); mlstm_scan(P);
#endif
    if (IN(4)) {
        { FBig R; float nrun = 0.f;
          if (bx < 256) fused_load(P, bx * 8, true, R);
          for (int gi = bx; gi < 256; gi += G)
              for (int i = 0; i < 8; ++i) { const int it = gi * 8 + i; const int nx = (i < 7) ? it + 1 : ((gi + G < 256) ? (gi + G) * 8 : -1);
                  mlstm_fused_item(P, it, nx, nrun, R, lds); } }
        attn_combine(P);
    #if REP_PHASE == 4
        __syncthreads();
        { FBig R; float nrun = 0.f;
          if (bx < 256) fused_load(P, bx * 8, true, R);
          for (int gi = bx; gi < 256; gi += G)
              for (int i = 0; i < 8; ++i) { const int it = gi * 8 + i; const int nx = (i < 7) ? it + 1 : ((gi + G < 256) ? (gi + G) * 8 : -1);
                  mlstm_fused_item(P, it, nx, nrun, R, lds); } }
        attn_combine(P);
    #endif
    }
    SEAM(4);
    if (IN(5)) {
        pg8::Gemm gm{(const pg8::bf16_t*)(ws + WS_MIX), (const pg8::bf16_t*)(ws + WS_WOUT), MT, DM, DM}; pg8::StaticOrder S; S.init(MT, DM, G, bx);
        pg8::EpiRes<false> E{P.in[0], (pg8::bf16_t*)(ws + WS_BUFB), (float*)(ws + WS_SSQ1)};
        pg8::gemm_phase_sp<pg8::EpiRes<false>, pg8::StaticOrder, true, true>(lds, gm, S, E);
#if REP_PHASE == 5
        __syncthreads(); pg8::gemm_phase_sp<pg8::EpiRes<false>, pg8::StaticOrder, true, true>(lds, gm, S, E);
#endif
    }
    SEAM(5);
    if (IN(6)) {
        pg8::Gemm gm{(const pg8::bf16_t*)(ws + WS_BUFB), (const pg8::bf16_t*)(ws + WS_WUP), MT, FF, DM}; pg8::StaticOrder S; S.init(MT, FF, G, bx);
        pg8::EpiUp E{(pg8::bf16_t*)(ws + WS_ACT), (const float*)(ws + WS_SSQ1)};
        pg8::gemm_phase_sp<pg8::EpiUp, pg8::StaticOrder, true, true>(lds, gm, S, E);
#if REP_PHASE == 6
        __syncthreads(); pg8::gemm_phase_sp<pg8::EpiUp, pg8::StaticOrder, true, true>(lds, gm, S, E);
#endif
    }
    SEAM(6);
    if (IN(7)) {
        pg8::Gemm gm{(const pg8::bf16_t*)(ws + WS_ACT), (const pg8::bf16_t*)(ws + WS_WDN), MT, DM, FF}; pg8::StaticOrder S; S.init(MT, DM, G, bx);
        pg8::EpiRes<true> E{ws + WS_BUFB, (pg8::bf16_t*)(ws + WS_BUFA), (float*)(ws + WS_SSQ2)};
        pg8::gemm_phase_sp<pg8::EpiRes<true>, pg8::StaticOrder, true, true>(lds, gm, S, E);
#if REP_PHASE == 7
        __syncthreads(); pg8::gemm_phase_sp<pg8::EpiRes<true>, pg8::StaticOrder, true, true>(lds, gm, S, E);
#endif
    }
    SEAM(7);
    if (IN(8)) {
        { pg8::Gemm gm{(const pg8::bf16_t*)(ws + WS_PB), (const pg8::bf16_t*)(ws + WS_WPLE), MT, DM, PLE}; pg8::StaticOrder S; S.init(MT, DM, G, bx);
          pg8::EpiStoreBf16 E{(pg8::bf16_t*)(ws + WS_BUFB), DM};
          pg8::gemm_phase_sp<pg8::EpiStoreBf16, pg8::StaticOrder, false, true>(lds, gm, S, E); }
        __syncthreads();
        { pg8::Gemm gm{(const pg8::bf16_t*)(ws + WS_BUFA), (const pg8::bf16_t*)(ws + WS_WPG), MT, DM, DM}; pg8::StaticOrder S; S.init(MT, DM, G, bx);
          pg8::EpiPle E{(const pg8::bf16_t*)(ws + WS_BUFA), (pg8::bf16_t*)(ws + WS_BUFB), (const float*)(ws + WS_SSQ2), (float*)(ws + WS_SSQ3)};
          pg8::gemm_phase_sp<pg8::EpiPle, pg8::StaticOrder, true, true>(lds, gm, S, E); }
#if REP_PHASE == 8
        __syncthreads();
        { pg8::Gemm gm{(const pg8::bf16_t*)(ws + WS_PB), (const pg8::bf16_t*)(ws + WS_WPLE), MT, DM, PLE}; pg8::StaticOrder S; S.init(MT, DM, G, bx);
          pg8::EpiStoreBf16 E{(pg8::bf16_t*)(ws + WS_BUFB), DM};
          pg8::gemm_phase_sp<pg8::EpiStoreBf16, pg8::StaticOrder, false, true>(lds, gm, S, E); }
        __syncthreads();
        { pg8::Gemm gm{(const pg8::bf16_t*)(ws + WS_BUFA), (const pg8::bf16_t*)(ws + WS_WPG), MT, DM, DM}; pg8::StaticOrder S; S.init(MT, DM, G, bx);
          pg8::EpiPle E{(const pg8::bf16_t*)(ws + WS_BUFA), (pg8::bf16_t*)(ws + WS_BUFB), (const float*)(ws + WS_SSQ2), (float*)(ws + WS_SSQ3)};
          pg8::gemm_phase_sp<pg8::EpiPle, pg8::StaticOrder, true, true>(lds, gm, S, E); }
#endif
    }
    SEAM(8);
    if (IN(9)) { final_norm(P); }
#if REP_PHASE == 9
    __syncthreads(); final_norm(P);
#endif
#undef IN
#undef SEAM
}

extern "C" void kernel_launch(void* const* d_in, const int* in_sizes, int n_in, void* d_out, int out_size, void* d_ws, size_t ws_size, hipStream_t stream) {
    static int grid = 0;
    if (grid == 0) {
        if (n_in != 16 || out_size != MT * DM || ws_size < WS_END) { fprintf(stderr, "kernel_launch: unexpected shapes (n_in %d out %d ws %zu)\n", n_in, out_size, ws_size); grid = -1; return; }
        int dev = 0, cus = 0, per_cu = 0;
        (void)hipGetDevice(&dev); (void)hipDeviceGetAttribute(&cus, hipDeviceAttributeMultiprocessorCount, dev);
        if (hipFuncSetAttribute((const void*)hymba_fwd, hipFuncAttributeMaxDynamicSharedMemorySize, LDS_BYTES) != hipSuccess) { fprintf(stderr, "kernel_launch: hipFuncSetAttribute failed\n"); grid = -1; return; }
        if (hipOccupancyMaxActiveBlocksPerMultiprocessor(&per_cu, (const void*)hymba_fwd, 512, LDS_BYTES) != hipSuccess || per_cu < 1) { fprintf(stderr, "kernel_launch: occupancy query gave %d\n", per_cu); per_cu = 1; }
        (void)hipGetLastError();
        grid = cus;
        fprintf(stderr, "kernel_launch: grid %d (occupancy %d per CU)\n", grid, per_cu);
    }
    if (grid < 0) return;
    (void)hipMemsetAsync((unsigned char*)d_ws + WS_CTL, 0, CTL_BYTES, stream);
    Params p{};
    for (int i = 0; i < 16; ++i) p.in[i] = (const float*)d_in[i];
    p.out = (float*)d_out; p.ws = (unsigned char*)d_ws;
#if MK_LAUNCHES == 1
    p.ph_lo = 0; p.ph_hi = 10;
    void* args[] = {&p};
    hipError_t e = hipLaunchCooperativeKernel((const void*)hymba_fwd, dim3(grid), dim3(512), args, LDS_BYTES, stream);
    if (e != hipSuccess) fprintf(stderr, "kernel_launch: cooperative launch failed: %s\n", hipGetErrorString(e));
#else
    for (int ph = 0; ph < 10; ++ph) { p.ph_lo = ph; p.ph_hi = ph + 1; hipLaunchKernelGGL(hymba_fwd, dim3(grid), dim3(512), LDS_BYTES, stream, p); }
#endif
}
```
